# Optimizing an MI355X kernel written in HIP

```python
import math
import jax, jax.numpy as jnp
from jax import lax
import numpy as np

D_MODEL = 2048
BATCH = 2
SEQ = 16384
DEPTH = 1

HEAD_DIM = 128
ATTN_HEADS = 8
GMLP_GROUPS = 8
ATTN_WIDTH = ATTN_HEADS * HEAD_DIM
GMLP_WIDTH = GMLP_GROUPS * HEAD_DIM
MIX_WIDTH = ATTN_WIDTH + GMLP_WIDTH
IN_PROJ_WIDTH = 3 * ATTN_WIDTH + 2 * GMLP_WIDTH
DILATION_BRANCHES = ((128, 1), (512, 4), (2048, 16))
BAND_BLOCK = 128
GMLP_CHUNK = 128
ROPE_THETA = 10000.0
MEM_LEN = 256
XATTN_HEADS = 4
XATTN_HEAD_DIM = D_MODEL // XATTN_HEADS
D_FF = -(-(8 * D_MODEL) // (3 * 256)) * 256
DEEPNORM_ALPHA = (2 * DEPTH) ** 0.25
DEEPNORM_BETA = (8 * DEPTH) ** -0.25
LN_EPS = 1e-5

kernel_name = "hymba_dilated_gmlp_deepnorm_layer"


def _layer_norm(x, g, b):
    xf = x.astype(jnp.float32)
    mu = jnp.mean(xf, axis=-1, keepdims=True)
    var = jnp.mean(jnp.square(xf - mu), axis=-1, keepdims=True)
    y = (xf - mu) * lax.rsqrt(var + LN_EPS) * g.astype(jnp.float32) + b.astype(jnp.float32)
    return y.astype(x.dtype)


def _rms_norm(x, g):
    xf = x.astype(jnp.float32)
    y = xf * lax.rsqrt(jnp.mean(jnp.square(xf), axis=-1, keepdims=True) + LN_EPS) * g.astype(jnp.float32)
    return y.astype(x.dtype)


def _rope(x, positions):
    half = x.shape[-1] // 2
    inv_freq = ROPE_THETA ** (-jnp.arange(half, dtype=jnp.float32) / half)
    ang = positions.astype(jnp.float32)[:, :, None] * inv_freq
    cos = jnp.cos(ang)[:, :, None, :]
    sin = jnp.sin(ang)[:, :, None, :]
    xf = x.astype(jnp.float32)
    x1, x2 = xf[..., :half], xf[..., half:]
    return jnp.concatenate([x1 * cos - x2 * sin, x2 * cos + x1 * sin], axis=-1).astype(x.dtype)


def _banded_causal_attention(q, k, v, reach):
    N, L, H, E = q.shape
    nb = -(-L // BAND_BLOCK)
    Lp = nb * BAND_BLOCK
    pad = ((0, 0), (0, Lp - L), (0, 0), (0, 0))
    qb = jnp.pad(q, pad).reshape(N, nb, BAND_BLOCK, H, E)
    kb = jnp.pad(k, pad).reshape(N, nb, BAND_BLOCK, H, E)
    vb = jnp.pad(v, pad).reshape(N, nb, BAND_BLOCK, H, E)

    def with_prev(t):
        prev = jnp.pad(t[:, :-1], ((0, 0), (1, 0), (0, 0), (0, 0), (0, 0)))
        return jnp.concatenate([prev, t], axis=2)

    kw, vw = with_prev(kb), with_prev(vb)
    s = jnp.einsum('nbqhe,nbkhe->nbhqk', qb, kw).astype(jnp.float32) * (E ** -0.5)
    qpos = jnp.arange(BAND_BLOCK)[:, None] + BAND_BLOCK
    kpos = jnp.arange(2 * BAND_BLOCK)[None, :]
    dist = qpos - kpos
    band = (dist >= 0) & (dist <= reach)
    prev_ok = (jnp.arange(nb)[:, None, None] > 0) | (kpos[None] >= BAND_BLOCK)
    mask = band[None] & prev_ok
    s = jnp.where(mask[None, :, None], s, -jnp.inf)
    lse = jax.nn.logsumexp(s, axis=-1)
    p = jnp.exp(s - lse[..., None])
    o = jnp.einsum('nbhqk,nbkhe->nbqhe', p.astype(v.dtype), vw)
    o = o.reshape(N, Lp, H, E)[:, :L]
    lse = lse.transpose(0, 1, 3, 2).reshape(N, Lp, H)[:, :L]
    return o, lse


def _dilated_attention(q, k, v):
    B, S, H, E = q.shape
    outs, lses = [], []
    for window, dil in DILATION_BRANCHES:
        reach = window // dil
        Ld = S // dil

        def to_strided(t):
            return t.reshape(B, Ld, dil, H, E).transpose(0, 2, 1, 3, 4).reshape(B * dil, Ld, H, E)

        o, lse = _banded_causal_attention(to_strided(q), to_strided(k), to_strided(v), reach)
        outs.append(o.reshape(B, dil, Ld, H, E).transpose(0, 2, 1, 3, 4).reshape(B, S, H, E))
        lses.append(lse.reshape(B, dil, Ld, H).transpose(0, 2, 1, 3).reshape(B, S, H))
    wts = jax.nn.softmax(jnp.stack(lses, axis=0), axis=0)
    out = jnp.einsum('rbsh,rbshe->bshe', wts, jnp.stack(outs, axis=0).astype(jnp.float32))
    return out.astype(q.dtype)


def _spatial_gating(u, g, norm_g, norm_b, w_s, b_s):
    B, S, _ = u.shape
    u = jax.nn.gelu(u, approximate=False)
    g = _layer_norm(jax.nn.gelu(g, approximate=False), norm_g, norm_b)
    gc = g.reshape(B, S // GMLP_CHUNK, GMLP_CHUNK, GMLP_GROUPS, HEAD_DIM)
    w = jnp.tril(w_s).astype(g.dtype)
    mixed = jnp.einsum('gij,bcjge->bcige', w, gc) + b_s.T[None, None, :, :, None]
    return u * mixed.reshape(B, S, GMLP_WIDTH)


def _memory_cross_attention(h, mem, w_q, w_k, w_v, w_o):
    B, S, D = h.shape
    M = mem.shape[1]
    q = (h @ w_q).reshape(B, S, XATTN_HEADS, XATTN_HEAD_DIM)
    k = (mem @ w_k).reshape(B, M, XATTN_HEADS, XATTN_HEAD_DIM)
    v = (mem @ w_v).reshape(B, M, XATTN_HEADS, XATTN_HEAD_DIM)
    s = jnp.einsum('bshe,bmhe->bhsm', q, k).astype(jnp.float32) * (XATTN_HEAD_DIM ** -0.5)
    p = jax.nn.softmax(s, axis=-1)
    o = jnp.einsum('bhsm,bmhe->bshe', p.astype(v.dtype), v).reshape(B, S, D)
    return o @ w_o


def setup_inputs(seed: int = 0) -> dict:
    key = jax.random.key(seed)
    ks = jax.random.split(key, 32)
    f32 = jnp.float32
    L = DEPTH
    D = D_MODEL

    def nrm(k, shape, scale):
        return jax.random.normal(k, shape, f32) * scale

    def gain(k, shape):
        return 1.0 + 0.02 * jax.random.normal(k, shape, f32)

    def bias(k, shape):
        return 0.02 * jax.random.normal(k, shape, f32)

    x = jax.random.normal(ks[0], (BATCH, SEQ, D), f32)
    mem = jax.random.normal(ks[1], (BATCH, MEM_LEN, D), f32)
    start = jax.random.randint(ks[2], (BATCH, 1), 0, 4096, dtype=jnp.int32)
    positions = start + jnp.arange(SEQ, dtype=jnp.int32)[None, :]

    col_scale = jnp.concatenate([jnp.ones((2 * ATTN_WIDTH,), f32),
                                 jnp.full((ATTN_WIDTH + 2 * GMLP_WIDTH,), DEEPNORM_BETA, f32)])
    w_in = nrm(ks[5], (L, D, IN_PROJ_WIDTH), D ** -0.5) * col_scale

    return {
        "x": x,
        "mem": mem,
        "positions": positions,
        "ln_in_g": gain(ks[3], (D,)),
        "ln_in_b": bias(ks[4], (D,)),
        "w_in": w_in,
        "sgu_norm_g": gain(ks[6], (L, GMLP_WIDTH)),
        "sgu_norm_b": bias(ks[7], (L, GMLP_WIDTH)),
        "w_spatial": nrm(ks[8], (L, GMLP_GROUPS, GMLP_CHUNK, GMLP_CHUNK), GMLP_CHUNK ** -0.5),
        "b_spatial": 1.0 + 0.1 * jax.random.normal(ks[9], (L, GMLP_GROUPS, GMLP_CHUNK), f32),
        "attn_out_g": gain(ks[10], (L, ATTN_WIDTH)),
        "gmlp_out_g": gain(ks[11], (L, GMLP_WIDTH)),
        "w_mix_out": nrm(ks[12], (L, MIX_WIDTH, D), DEEPNORM_BETA * MIX_WIDTH ** -0.5),
        "ln1_g": gain(ks[13], (L, D)),
        "ln1_b": bias(ks[14], (L, D)),
        "w_xq": nrm(ks[15], (L, D, D), D ** -0.5),
        "w_xk": nrm(ks[16], (L, D, D), D ** -0.5),
        "w_xv": nrm(ks[17], (L, D, D), DEEPNORM_BETA * D ** -0.5),
        "w_xo": nrm(ks[18], (L, D, D), DEEPNORM_BETA * D ** -0.5),
        "ln2_g": gain(ks[19], (L, D)),
        "ln2_b": bias(ks[20], (L, D)),
        "w_ffn_gate": nrm(ks[21], (L, D, D_FF), DEEPNORM_BETA * D ** -0.5),
        "w_ffn_up": nrm(ks[22], (L, D, D_FF), DEEPNORM_BETA * D ** -0.5),
        "w_ffn_down": nrm(ks[23], (L, D_FF, D), DEEPNORM_BETA * D_FF ** -0.5),
        "ln3_g": gain(ks[24], (L, D)),
        "ln3_b": bias(ks[25], (L, D)),
    }


def reference(x, mem, positions, ln_in_g, ln_in_b, w_in, sgu_norm_g, sgu_norm_b,
              w_spatial, b_spatial, attn_out_g, gmlp_out_g, w_mix_out, ln1_g, ln1_b,
              w_xq, w_xk, w_xv, w_xo, ln2_g, ln2_b, w_ffn_gate, w_ffn_up, w_ffn_down,
              ln3_g, ln3_b):
    B, S, D = x.shape
    h = _layer_norm(x, ln_in_g, ln_in_b)
    for l in range(DEPTH):
        proj = h @ w_in[l]
        q, k, v, u, g = jnp.split(
            proj, [ATTN_WIDTH, 2 * ATTN_WIDTH, 3 * ATTN_WIDTH, 3 * ATTN_WIDTH + GMLP_WIDTH], axis=-1)
        q = _rope(q.reshape(B, S, ATTN_HEADS, HEAD_DIM), positions)
        k = _rope(k.reshape(B, S, ATTN_HEADS, HEAD_DIM), positions)
        v = v.reshape(B, S, ATTN_HEADS, HEAD_DIM)
        attn = _dilated_attention(q, k, v).reshape(B, S, ATTN_WIDTH)
        gm = _spatial_gating(u, g, sgu_norm_g[l], sgu_norm_b[l], w_spatial[l], b_spatial[l])
        mixed = jnp.concatenate([_rms_norm(attn, attn_out_g[l]),
                                 _rms_norm(gm, gmlp_out_g[l])], axis=-1) @ w_mix_out[l]
        h = _layer_norm(DEEPNORM_ALPHA * h + mixed, ln1_g[l], ln1_b[l])
        xa = _memory_cross_attention(h, mem, w_xq[l], w_xk[l], w_xv[l], w_xo[l])
        h = _layer_norm(DEEPNORM_ALPHA * h + xa, ln2_g[l], ln2_b[l])
        ff = (jax.nn.silu(h @ w_ffn_gate[l]) * (h @ w_ffn_up[l])) @ w_ffn_down[l]
        h = _layer_norm(DEEPNORM_ALPHA * h + ff, ln3_g[l], ln3_b[l])
    return h
```

```cpp
#include <hip/hip_runtime.h>
#include <hip/hip_cooperative_groups.h>
#include <cstdio>
namespace cg = cooperative_groups;
#ifndef GEMM_SP2
#define GEMM_SP2 1
#endif
#ifndef GEMM_ALIGN
#define GEMM_ALIGN 1
#endif
#ifndef PROBE_MASK
#define PROBE_MASK 0
#endif

#define LAS __attribute__((address_space(3)))
typedef unsigned short bf16_t;
typedef short bf16x8 __attribute__((ext_vector_type(8)));
typedef short s16x4 __attribute__((ext_vector_type(4)));
typedef float f32x4 __attribute__((ext_vector_type(4)));
typedef float f32x2 __attribute__((ext_vector_type(2)));
typedef unsigned u32x4 __attribute__((ext_vector_type(4)));
typedef unsigned u32x2 __attribute__((ext_vector_type(2)));

constexpr int DM = 2048, SEQ = 16384, NB = 2, T = NB * SEQ, NHEAD = 8, AW = 1024, NIN = 5120, MEMLEN = 256, DFF = 5632;
constexpr float ALPHA = 1.189207115002721f, LN_EPS = 1e-5f;
constexpr size_t MiB = 1u << 20;
constexpr size_t WS_WIN = 0, WS_WMIX = 20 * MiB, WS_WXQ = 28 * MiB, WS_WXK = 36 * MiB, WS_WXV = 44 * MiB, WS_WXO = 52 * MiB, WS_WGU = 60 * MiB, WS_WDN = 104 * MiB;
constexpr size_t WS_R0 = 126 * MiB;
constexpr size_t WS_R1 = 254 * MiB;
constexpr size_t WS_R2 = 574 * MiB;
constexpr size_t WS_R3 = 766 * MiB;
constexpr size_t WS_ROPE = 894 * MiB, WS_LSE = 910 * MiB, WS_MEMB = 913 * MiB, WS_KX = 915 * MiB, WS_VT = 917 * MiB, WS_WSP = 919 * MiB, WS_WQK = 920 * MiB, WS_VWO = 928 * MiB, WS_BAR = 936 * MiB, WS_END = 937 * MiB;

struct Params {
    const float* x; const float* mem; const int* pos; const float* ln_in_g; const float* ln_in_b; const float* w_in;
    const float* sgu_g; const float* sgu_b; const float* w_sp; const float* b_sp; const float* attn_g; const float* gmlp_g; const float* w_mix;
    const float* ln1_g; const float* ln1_b; const float* w_xq; const float* w_xk; const float* w_xv; const float* w_xo; const float* ln2_g; const float* ln2_b;
    const float* w_gate; const float* w_up; const float* w_down; const float* ln3_g; const float* ln3_b;
    float* out; unsigned char* ws;
};

__device__ __forceinline__ unsigned cvt_pk_bf16(float lo, float hi) { unsigned r; asm volatile("v_cvt_pk_bf16_f32 %0, %1, %2" : "=v"(r) : "v"(lo), "v"(hi)); return r; }
__device__ __forceinline__ float bf_lo(unsigned w) { return __uint_as_float(w << 16); }
__device__ __forceinline__ float bf_hi(unsigned w) { return __uint_as_float(w & 0xffff0000u); }
__device__ __forceinline__ float wave_sum(float v) {
#pragma unroll
    for (int o = 32; o >= 1; o >>= 1) v += __shfl_xor(v, o);
    return v;
}
__device__ __forceinline__ f32x2 gelu_pk(f32x2 v) {
    const f32x2 av = __builtin_elementwise_abs(v), d = av * 0.2316418882f + 1.0f;
    f32x2 t; t.x = __builtin_amdgcn_rcpf(d.x); t.y = __builtin_amdgcn_rcpf(d.y);
    f32x2 q = t * 0.5307027145f + (-0.7265760135f); q = q * t + 0.7107068705f; q = q * t + (-0.142248368f); q = q * t + 0.127414796f; q = q * t;
    const f32x2 s = (v * v) * (-0.72134752044f);
    f32x2 e; e.x = __builtin_amdgcn_exp2f(s.x); e.y = __builtin_amdgcn_exp2f(s.y);
    const f32x2 m = v * (q * e), r = v - m;
    f32x2 o; o.x = v.x < 0.f ? m.x : r.x; o.y = v.y < 0.f ? m.y : r.y; return o;
}
__device__ __forceinline__ f32x4 gelu4(f32x4 v) { const f32x2 a = gelu_pk((f32x2){v[0], v[1]}), b = gelu_pk((f32x2){v[2], v[3]}); return (f32x4){a.x, a.y, b.x, b.y}; }
__device__ __forceinline__ float silu_f(float g) { return g * __builtin_amdgcn_rcpf(1.0f + __builtin_amdgcn_exp2f(-1.4426950408889634f * g)); }
__device__ __forceinline__ unsigned off_b(unsigned row, unsigned ch) { return 256u * row + 16u * (ch ^ (((row & 3) << 2) | ((row >> 2) & 3))); }

namespace pg8 {
constexpr int BM = 256, BK = 64, HALF = 128, HTB = HALF * BK * 2, STAGE_BYTES = 8 * HTB, NXCD = 8, WGM = 8;
__device__ __forceinline__ int lds_byte(int r, int c) { const int st = (r >> 4) * 2 + (c >> 5), rr = r & 15, cc = c & 31, ob = rr * 64 + cc * 2; return st * 1024 + (ob ^ (((ob >> 9) & 1) << 5)); }
__device__ __forceinline__ void stage_rc(int b, int& R, int& C) { const int st = b / 1024, sb = b % 1024, swz = sb ^ (((sb >> 9) & 1) << 5); R = (st >> 1) * 16 + swz / 64; C = (st & 1) * 32 + (swz % 64) / 2; }
__device__ __forceinline__ int perm32(int rho) { const int n = rho >> 4, i = rho & 15; return 8 * (i >> 2) + 4 * n + (i & 3); }
struct Unit { int pm, pn; };
struct Gemm { const bf16_t* A; const bf16_t* Bt; int lda, ldb, K, a_sh, a_mask, b_mask, b_sh; long a_pm, a_pn, b_pn, b_pn2, b_pb;
    __device__ __forceinline__ const char* aptr(const Unit& u) const { return (const char*)(A + (long)u.pm * a_pm + (long)((u.pn >> a_sh) & a_mask) * a_pn); }
    __device__ __forceinline__ const char* bptr(const Unit& u) const { return (const char*)(Bt + (long)(u.pn & b_mask) * b_pn + (long)(u.pn >> b_sh) * b_pn2 + (long)(u.pm >> 6) * b_pb); } };
__device__ __forceinline__ Gemm make_gemm(const bf16_t* A, int lda, const bf16_t* Bt, int ldb, int K) { Gemm g; g.A = A; g.Bt = Bt; g.lda = lda; g.ldb = ldb; g.K = K; g.a_sh = 0; g.a_mask = 0; g.b_mask = 0x7fffffff; g.b_sh = 31;
    g.a_pm = 256L * lda; g.a_pn = 0; g.b_pn = 256L * ldb; g.b_pn2 = 0; g.b_pb = 0; return g; }
__device__ __forceinline__ Gemm plain_gemm(const bf16_t* A, const bf16_t* Bt, int K) { return make_gemm(A, K, Bt, K, K); }
struct StaticOrder {
    int nM, nN, nwg, G, c;
    __device__ void init(int nM_, int nN_, int G_, int c_) { nM = nM_; nN = nN_; nwg = nM * nN; G = G_; c = c_; }
    __device__ bool next(int i, Unit& u) const {
        const long L = (long)i * G + c; if (L >= nwg) return false;
        int wgid = (int)L; { const int q = nwg / NXCD, r = nwg % NXCD, xcd = wgid % NXCD, off = wgid / NXCD; wgid = (xcd < r ? xcd * (q + 1) : r * (q + 1) + (xcd - r) * q) + off; }
        const int nig = WGM * nN, gid = wgid / nig, fm = gid * WGM, gsz = (nM - fm) < WGM ? (nM - fm) : WGM;
        u.pm = fm + ((wgid % nig) % gsz); u.pn = (wgid % nig) / gsz; return true;
    }
};

template <class Epi>
__device__ __forceinline__ void gemm_phase(LAS unsigned char* lds, const Gemm g, const StaticOrder& S, const Epi& E) {
    int tid = threadIdx.x; asm volatile("" : "+v"(tid));
    const int wid = __builtin_amdgcn_readfirstlane(tid >> 6), lane = tid & 63, wr = wid >> 2, wc = wid & 3, fr = lane & 15, fq = lane >> 4;
    const int K = g.K, nt = K / BK;
    unsigned voffA[2], voffB[2];
#pragma unroll
    for (int i = 0; i < 2; ++i) { int R, C; stage_rc(tid * 16 + i * 8192, R, C); const int Rb = Epi::PERM ? ((R & ~31) + perm32(R & 31)) : R;
        voffA[i] = (unsigned)(R * g.lda + C) * 2u; voffB[i] = (unsigned)(Rb * g.ldb + C) * 2u; }
    const size_t kstep = (size_t)(BK * 2);
    const size_t hA = (size_t)HALF * g.lda * 2, hB = (size_t)HALF * g.ldb * 2;
    const unsigned ldsw = (unsigned)wid * 1024u;
    const int aoff = lds_byte(wr * 64 + fr, fq * 8), boff = lds_byte(wc * 32 + fr, fq * 8);
#define PG8_SA(b, h) (((b) * 2 + (h)) * HTB)
#define PG8_SB(b, h) ((4 + (b) * 2 + (h)) * HTB)
#define PG8_STAGE(bufoff, gbase, voff) do { _Pragma("unroll") for (int _i = 0; _i < 2; ++_i) \
        __builtin_amdgcn_global_load_lds((const unsigned*)((const char*)(gbase) + (voff)[_i]), (LAS unsigned*)(lds + (bufoff) + ldsw + _i * 8192), 16, 0, 0); } while (0)
#define PG8_LDA(dst, b, h) do { _Pragma("unroll") for (int m = 0; m < 4; ++m) _Pragma("unroll") for (int k = 0; k < 2; ++k) dst[m][k] = *(const LAS bf16x8*)(lds + PG8_SA(b, h) + aoff + m * 2048 + k * 1024); } while (0)
#define PG8_LDB(dst, b, h) do { _Pragma("unroll") for (int n = 0; n < 2; ++n) _Pragma("unroll") for (int k = 0; k < 2; ++k) dst[n][k] = *(const LAS bf16x8*)(lds + PG8_SB(b, h) + boff + n * 2048 + k * 1024); } while (0)
#define PG8_MMA(ai, bj, At, Bt) do { __builtin_amdgcn_s_setprio(1); _Pragma("unroll") for (int m = 0; m < 4; ++m) _Pragma("unroll") for (int n = 0; n < 2; ++n) _Pragma("unroll") for (int k = 0; k < 2; ++k) \
        acc[ai][bj][m][n] = __builtin_amdgcn_mfma_f32_16x16x32_bf16(Bt[n][k], At[m][k], acc[ai][bj][m][n], 0, 0, 0); __builtin_amdgcn_s_setprio(0); } while (0)
#define PG8_WAIT_V(n) asm volatile("s_waitcnt vmcnt(" #n ")" ::: "memory")
#define PG8_WAIT_L(n) asm volatile("s_waitcnt lgkmcnt(" #n ")" ::: "memory")
#define PG8_BAR __builtin_amdgcn_s_barrier()
#define PG8_SCHED __builtin_amdgcn_sched_barrier(0)
    Unit cur, nxt; int ui = 0;
    if (!S.next(0, cur)) return;
    f32x4 acc[2][2][4][2];
#pragma unroll
    for (int a = 0; a < 2; ++a)
#pragma unroll
        for (int b = 0; b < 2; ++b)
#pragma unroll
            for (int m = 0; m < 4; ++m)
#pragma unroll
                for (int n = 0; n < 2; ++n) acc[a][b][m][n] = (f32x4){0.f, 0.f, 0.f, 0.f};
    bf16x8 At[4][2], B0[2][2], B1[2][2];
    const char* cA = g.aptr(cur); const char* cB = g.bptr(cur);
#if GEMM_SP2
    PG8_STAGE(PG8_SB(0, 0), cB, voffB); PG8_STAGE(PG8_SB(0, 1), cB + hB, voffB); PG8_STAGE(PG8_SA(0, 0), cA, voffA); PG8_STAGE(PG8_SA(0, 1), cA + hA, voffA);
    if (wr == 1) PG8_BAR;
    PG8_WAIT_V(2); PG8_BAR;
    PG8_STAGE(PG8_SB(1, 0), cB + kstep, voffB); PG8_STAGE(PG8_SA(1, 0), cA + kstep, voffA); PG8_STAGE(PG8_SB(1, 1), cB + hB + kstep, voffB);
    PG8_WAIT_V(6); PG8_BAR;
#else
    PG8_STAGE(PG8_SB(0, 0), cB, voffB); PG8_STAGE(PG8_SA(0, 0), cA, voffA); PG8_STAGE(PG8_SB(0, 1), cB + hB, voffB); PG8_STAGE(PG8_SA(0, 1), cA + hA, voffA);
    if (wr == 1) PG8_BAR;
    PG8_WAIT_V(4); PG8_BAR;
    PG8_STAGE(PG8_SB(1, 0), cB + kstep, voffB); PG8_STAGE(PG8_SA(1, 0), cA + kstep, voffA); PG8_STAGE(PG8_SB(1, 1), cB + hB + kstep, voffB);
    PG8_WAIT_V(6); PG8_BAR;
#endif
    for (;;) {
        const bool has_next = S.next(ui + 1, nxt);
        const char* nA = has_next ? g.aptr(nxt) : cA; const char* nB = has_next ? g.bptr(nxt) : cB;
        for (int t = 0; t < nt; t += 2) {
            const bool last = (t == nt - 2);
            const char* a1 = cA + (size_t)(t + 1) * kstep;
            const char* a2 = last ? nA : cA + (size_t)(t + 2) * kstep; const char* b2 = last ? nB : cB + (size_t)(t + 2) * kstep;
            const char* a3 = a2 + kstep; const char* b3 = b2 + kstep;
#if GEMM_SP2
            PG8_LDB(B0, 0, 0); PG8_LDB(B1, 0, 1); PG8_SCHED; PG8_LDA(At, 0, 0); PG8_STAGE(PG8_SA(1, 1), a1 + hA, voffA);
            PG8_WAIT_V(8); PG8_WAIT_L(0); PG8_BAR; PG8_MMA(0, 0, At, B0); PG8_MMA(0, 1, At, B1); PG8_BAR; PG8_SCHED;
            PG8_LDA(At, 0, 1); PG8_STAGE(PG8_SB(0, 0), b2, voffB); PG8_STAGE(PG8_SB(0, 1), b2 + hB, voffB); PG8_STAGE(PG8_SA(0, 0), a2, voffA);
            PG8_WAIT_V(8); PG8_WAIT_L(0); PG8_BAR; PG8_MMA(1, 0, At, B0); PG8_MMA(1, 1, At, B1); PG8_BAR; PG8_SCHED;
            PG8_LDB(B0, 1, 0); PG8_LDB(B1, 1, 1); PG8_SCHED; PG8_LDA(At, 1, 0); PG8_STAGE(PG8_SA(0, 1), a2 + hA, voffA);
            PG8_WAIT_V(8); PG8_WAIT_L(0); PG8_BAR; PG8_MMA(0, 0, At, B0); PG8_MMA(0, 1, At, B1); PG8_BAR; PG8_SCHED;
            PG8_LDA(At, 1, 1); PG8_STAGE(PG8_SB(1, 0), b3, voffB); PG8_STAGE(PG8_SB(1, 1), b3 + hB, voffB); PG8_STAGE(PG8_SA(1, 0), a3, voffA);
            PG8_WAIT_V(8); PG8_WAIT_L(0); PG8_BAR; PG8_MMA(1, 0, At, B0); PG8_MMA(1, 1, At, B1); PG8_BAR; PG8_SCHED;
#else
            PG8_LDB(B0, 0, 0); PG8_SCHED; PG8_LDA(At, 0, 0); PG8_STAGE(PG8_SA(1, 1), a1 + hA, voffA);
            PG8_WAIT_L(8); PG8_BAR; PG8_WAIT_L(0); PG8_MMA(0, 0, At, B0); PG8_BAR; PG8_SCHED;
            PG8_LDB(B1, 0, 1); PG8_STAGE(PG8_SB(0, 0), b2, voffB);
            PG8_BAR; PG8_WAIT_L(0); PG8_MMA(0, 1, At, B1); PG8_BAR;
            PG8_LDA(At, 0, 1); PG8_STAGE(PG8_SA(0, 0), a2, voffA);
            PG8_BAR; PG8_WAIT_L(0); PG8_MMA(1, 0, At, B0); PG8_BAR; PG8_SCHED;
            PG8_STAGE(PG8_SB(0, 1), b2 + hB, voffB);
            PG8_WAIT_V(6); PG8_BAR; PG8_MMA(1, 1, At, B1); PG8_BAR;
            PG8_LDB(B0, 1, 0); PG8_SCHED; PG8_LDA(At, 1, 0); PG8_STAGE(PG8_SA(0, 1), a2 + hA, voffA);
            PG8_WAIT_L(8); PG8_BAR; PG8_WAIT_L(0); PG8_MMA(0, 0, At, B0); PG8_BAR; PG8_SCHED;
            PG8_LDB(B1, 1, 1); PG8_STAGE(PG8_SB(1, 0), b3, voffB);
            PG8_BAR; PG8_WAIT_L(0); PG8_MMA(0, 1, At, B1); PG8_BAR;
            PG8_LDA(At, 1, 1); PG8_STAGE(PG8_SA(1, 0), a3, voffA);
            PG8_BAR; PG8_WAIT_L(0); PG8_MMA(1, 0, At, B0); PG8_BAR; PG8_SCHED;
            PG8_STAGE(PG8_SB(1, 1), b3 + hB, voffB);
            PG8_WAIT_V(6); PG8_BAR; PG8_MMA(1, 1, At, B1); PG8_BAR;
#endif
        }
#if GEMM_ALIGN
        if (wr == 0) PG8_BAR;
#endif
        E(acc, cur, wr, wc, fr, fq, lds);
        if (!has_next) break;
#pragma unroll
        for (int a = 0; a < 2; ++a)
#pragma unroll
            for (int b = 0; b < 2; ++b)
#pragma unroll
                for (int m = 0; m < 4; ++m)
#pragma unroll
                    for (int n = 0; n < 2; ++n) acc[a][b][m][n] = (f32x4){0.f, 0.f, 0.f, 0.f};
        cur = nxt; cA = nA; cB = nB; ++ui;
#if GEMM_ALIGN
        if (wr == 1) PG8_BAR;
#endif
    }
    PG8_WAIT_V(0);
#if !GEMM_ALIGN
    if (wr == 0) PG8_BAR;
#endif
    PG8_BAR;
#undef PG8_SA
#undef PG8_SB
#undef PG8_STAGE
#undef PG8_LDA
#undef PG8_LDB
#undef PG8_MMA
#undef PG8_WAIT_V
#undef PG8_WAIT_L
#undef PG8_BAR
#undef PG8_SCHED
}
}
using pg8::Unit;

__device__ __forceinline__ u32x4 pack8(f32x4 a, f32x4 b) { u32x4 w; w.x = cvt_pk_bf16(a[0], a[1]); w.y = cvt_pk_bf16(a[2], a[3]); w.z = cvt_pk_bf16(b[0], b[1]); w.w = cvt_pk_bf16(b[2], b[3]); return w; }

struct EpiInProj {
    static constexpr bool PERM = true;
    bf16_t* base; const float* rope;
    __device__ __forceinline__ void operator()(const f32x4 (&acc)[2][2][4][2], const Unit& un, int wr, int wc, int fr, int fq, LAS unsigned char*) const {
        const int row0 = un.pm * 256 + wr * 64 + fr, pn = un.pn;
        if (pn < 8) {
            bf16_t* dst = base + (size_t)(pn >> 2) * ((size_t)T * 1024); const int head = (pn & 3) * 2 + (wc >> 1), e1 = (wc & 1) * 32 + fq * 8;
            f32x4 rr[2][4];
            { const float* rp = rope + ((size_t)row0 * 64 + e1) * 2; rr[0][0] = *(const f32x4*)rp; rr[0][1] = *(const f32x4*)(rp + 4); rr[0][2] = *(const f32x4*)(rp + 8); rr[0][3] = *(const f32x4*)(rp + 12); }
#pragma unroll
            for (int it = 0; it < 8; ++it) {
                const int ai = it >> 2, m = it & 3, row = row0 + ai * 128 + m * 16;
                if (it < 7) { const int ai2 = (it + 1) >> 2, m2 = (it + 1) & 3; const float* rp = rope + ((size_t)(row0 + ai2 * 128 + m2 * 16) * 64 + e1) * 2;
                    rr[(it + 1) & 1][0] = *(const f32x4*)rp; rr[(it + 1) & 1][1] = *(const f32x4*)(rp + 4); rr[(it + 1) & 1][2] = *(const f32x4*)(rp + 8); rr[(it + 1) & 1][3] = *(const f32x4*)(rp + 12); }
                const f32x4 r0 = rr[it & 1][0], r1 = rr[it & 1][1], r2 = rr[it & 1][2], r3 = rr[it & 1][3];
                const f32x4 xa0 = acc[ai][0][m][0], xa1 = acc[ai][0][m][1], xb0 = acc[ai][1][m][0], xb1 = acc[ai][1][m][1];
                const f32x4 c0 = (f32x4){r0[0], r0[2], r1[0], r1[2]}, s0 = (f32x4){r0[1], r0[3], r1[1], r1[3]};
                const f32x4 c1 = (f32x4){r2[0], r2[2], r3[0], r3[2]}, s1 = (f32x4){r2[1], r2[3], r3[1], r3[3]};
                const float qs = (pn < 4) ? 0.08838834764831845f * 1.4426950408889634f : 1.0f;
                const f32x4 oa0 = (xa0 * c0 - xb0 * s0) * qs, oa1 = (xa1 * c1 - xb1 * s1) * qs, ob0 = (xb0 * c0 + xa0 * s0) * qs, ob1 = (xb1 * c1 + xa1 * s1) * qs;
                bf16_t* dp = dst + ((size_t)head * T + row) * 128 + e1;
                *(u32x4*)dp = pack8(oa0, oa1); *(u32x4*)(dp + 64) = pack8(ob0, ob1);
            }
        } else {
            bf16_t* dst = base + (size_t)(pn >> 2) * ((size_t)T * 1024); const bool act = pn >= 12; const int within = wc * 32 + 8 * fq;
#pragma unroll
            for (int ai = 0; ai < 2; ++ai)
#pragma unroll
                for (int m = 0; m < 4; ++m) {
                    const int row = row0 + ai * 128 + m * 16;
#pragma unroll
                    for (int bj = 0; bj < 2; ++bj) { f32x4 v0 = acc[ai][bj][m][0], v1 = acc[ai][bj][m][1];
                        if (act) { v0 = gelu4(v0); v1 = gelu4(v1); }
                        *(u32x4*)(dst + ((size_t)((pn & 3) * 2 + bj) * T + row) * 128 + within) = pack8(v0, v1); }
                }
        }
    }
};
struct EpiBf16 {
    static constexpr bool PERM = true;
    bf16_t* O; int ldc; int pm_rows, rsh, pn_rows, cmask;
    __device__ __forceinline__ void operator()(const f32x4 (&acc)[2][2][4][2], const Unit& un, int wr, int wc, int fr, int fq, LAS unsigned char*) const {
        const int row0 = un.pm * pm_rows + (un.pn >> rsh) * pn_rows + wr * 64 + fr, col0 = (un.pn & cmask) * 256 + wc * 32 + 8 * fq;
#pragma unroll
        for (int ai = 0; ai < 2; ++ai)
#pragma unroll
            for (int m = 0; m < 4; ++m) { bf16_t* dp = O + (size_t)(row0 + ai * 128 + m * 16) * ldc + col0;
#pragma unroll
                for (int bj = 0; bj < 2; ++bj) *(u32x4*)(dp + bj * 128) = pack8(acc[ai][bj][m][0], acc[ai][bj][m][1]); }
    }
};
__device__ __forceinline__ EpiBf16 plain_epi(bf16_t* O, int ldc) { EpiBf16 e; e.O = O; e.ldc = ldc; e.pm_rows = 256; e.rsh = 31; e.pn_rows = 0; e.cmask = 0x7fffffff; return e; }
struct EpiResBf16 {
    static constexpr bool PERM = true;
    const bf16_t* h; bf16_t* Y;
    __device__ __forceinline__ void operator()(const f32x4 (&acc)[2][2][4][2], const Unit& un, int wr, int wc, int fr, int fq, LAS unsigned char*) const {
        const int row0 = un.pm * 256 + wr * 64 + fr, col0 = un.pn * 256 + wc * 32 + 8 * fq;
        u32x4 hv[2][4][2];
#define RES_LOAD(ai_) do { _Pragma("unroll") for (int m = 0; m < 4; ++m) _Pragma("unroll") for (int bj = 0; bj < 2; ++bj) \
            hv[ai_][m][bj] = *(const u32x4*)(h + (size_t)(row0 + (ai_) * 128 + m * 16) * DM + col0 + bj * 128); } while (0)
        RES_LOAD(0); RES_LOAD(1);
#undef RES_LOAD
#pragma unroll
        for (int ai = 0; ai < 2; ++ai)
#pragma unroll
            for (int m = 0; m < 4; ++m)
#pragma unroll
                for (int bj = 0; bj < 2; ++bj) { const u32x4 v = hv[ai][m][bj];
                    const f32x4 h0v = (f32x4){bf_lo(v.x), bf_hi(v.x), bf_lo(v.y), bf_hi(v.y)}, h1v = (f32x4){bf_lo(v.z), bf_hi(v.z), bf_lo(v.w), bf_hi(v.w)};
                    *(u32x4*)(Y + (size_t)(row0 + ai * 128 + m * 16) * DM + col0 + bj * 128) = pack8(h0v * ALPHA + acc[ai][bj][m][0], h1v * ALPHA + acc[ai][bj][m][1]); }
    }
};
struct EpiGateUp {
    static constexpr bool PERM = true;
    bf16_t* act;
    __device__ __forceinline__ void operator()(const f32x4 (&acc)[2][2][4][2], const Unit& un, int wr, int wc, int fr, int fq, LAS unsigned char*) const {
        const int row0 = un.pm * 256 + wr * 64 + fr, col0 = un.pn * 128 + wc * 32 + 8 * fq;
#pragma unroll
        for (int ai = 0; ai < 2; ++ai)
#pragma unroll
            for (int m = 0; m < 4; ++m) { f32x4 o0, o1;
#pragma unroll
                for (int j = 0; j < 4; ++j) {
                    const float g0 = acc[ai][0][m][0][j], g1 = acc[ai][0][m][1][j];
                    o0[j] = g0 * acc[ai][1][m][0][j] * __builtin_amdgcn_rcpf(1.0f + __builtin_amdgcn_exp2f(g0));
                    o1[j] = g1 * acc[ai][1][m][1][j] * __builtin_amdgcn_rcpf(1.0f + __builtin_amdgcn_exp2f(g1)); }
                *(u32x4*)(act + (size_t)(row0 + ai * 128 + m * 16) * DFF + col0) = pack8(o0, o1); }
    }
};
struct EpiNull {
    static constexpr bool PERM = true;
    float* sink;
    __device__ __forceinline__ void operator()(const f32x4 (&acc)[2][2][4][2], const Unit& un, int wr, int wc, int fr, int fq, LAS unsigned char*) const {
        float s = 0.f;
#pragma unroll
        for (int ai = 0; ai < 2; ++ai)
#pragma unroll
            for (int bj = 0; bj < 2; ++bj)
#pragma unroll
                for (int m = 0; m < 4; ++m)
#pragma unroll
                    for (int n = 0; n < 2; ++n) s += (acc[ai][bj][m][n][0] + acc[ai][bj][m][n][1]) + (acc[ai][bj][m][n][2] + acc[ai][bj][m][n][3]);
        if (s == 12345.678f) sink[un.pm + fr] = s;
    }
};
struct EpiSoftmax {
    static constexpr bool PERM = true;
    bf16_t* Pm; float scale;
    __device__ __forceinline__ void operator()(f32x4 (&acc)[2][2][4][2], const Unit& un, int wr, int wc, int fr, int fq, LAS unsigned char* lds) const {
        LAS float* tM = (LAS float*)(lds + pg8::STAGE_BYTES); LAS float* tS = tM + 1024;
        float mx[2][4];
#pragma unroll
        for (int ai = 0; ai < 2; ++ai)
#pragma unroll
            for (int m = 0; m < 4; ++m) { float v = -3.0e38f;
#pragma unroll
                for (int bj = 0; bj < 2; ++bj)
#pragma unroll
                    for (int n = 0; n < 2; ++n) { acc[ai][bj][m][n] = acc[ai][bj][m][n] * scale; const f32x4 x = acc[ai][bj][m][n]; v = fmaxf(v, fmaxf(fmaxf(x[0], x[1]), fmaxf(x[2], x[3]))); }
                v = fmaxf(v, __shfl_xor(v, 16)); v = fmaxf(v, __shfl_xor(v, 32));
                if (fq == 0) tM[(ai * 128 + wr * 64 + m * 16 + fr) * 4 + wc] = v; }
        asm volatile("s_waitcnt lgkmcnt(0)" ::: "memory"); __builtin_amdgcn_s_barrier(); asm volatile("" ::: "memory");
#pragma unroll
        for (int ai = 0; ai < 2; ++ai)
#pragma unroll
            for (int m = 0; m < 4; ++m) { const f32x4 t = *(const LAS f32x4*)(tM + (ai * 128 + wr * 64 + m * 16 + fr) * 4);
                const float mm = fmaxf(fmaxf(t[0], t[1]), fmaxf(t[2], t[3])); float s = 0.f;
#pragma unroll
                for (int bj = 0; bj < 2; ++bj)
#pragma unroll
                    for (int n = 0; n < 2; ++n) { f32x4 x = acc[ai][bj][m][n];
#pragma unroll
                        for (int j = 0; j < 4; ++j) { x[j] = __builtin_amdgcn_exp2f(x[j] - mm); s += x[j]; }
                        acc[ai][bj][m][n] = x; }
                s += __shfl_xor(s, 16); s += __shfl_xor(s, 32);
                if (fq == 0) tS[(ai * 128 + wr * 64 + m * 16 + fr) * 4 + wc] = s; mx[ai][m] = mm; }
        asm volatile("s_waitcnt lgkmcnt(0)" ::: "memory"); __builtin_amdgcn_s_barrier(); asm volatile("" ::: "memory");
        const int row0 = un.pm * 256 + wr * 64 + fr, col0 = wc * 32 + 8 * fq;
#pragma unroll
        for (int ai = 0; ai < 2; ++ai)
#pragma unroll
            for (int m = 0; m < 4; ++m) { const f32x4 t = *(const LAS f32x4*)(tS + (ai * 128 + wr * 64 + m * 16 + fr) * 4);
                const float inv = 1.0f / ((t[0] + t[1]) + (t[2] + t[3]));
                bf16_t* dp = Pm + (size_t)(row0 + ai * 128 + m * 16) * 1024 + un.pn * 256 + col0;
#pragma unroll
                for (int bj = 0; bj < 2; ++bj) *(u32x4*)(dp + bj * 128) = pack8(acc[ai][bj][m][0] * inv, acc[ai][bj][m][1] * inv); }
        (void)mx;
    }
};
template <class E> struct EpiWrap { static constexpr bool PERM = E::PERM; E e;
    __device__ __forceinline__ void operator()(f32x4 (&acc)[2][2][4][2], const Unit& un, int wr, int wc, int fr, int fq, LAS unsigned char* lds) const { e(acc, un, wr, wc, fr, fq, lds); } };

template <bool IN_BF16> struct LnRaw { u32x4 r[IN_BF16 ? 4 : 8]; };
template <bool IN_BF16>
__device__ __forceinline__ void ln_load(const void* src, int row, int lane, LnRaw<IN_BF16>& raw) {
    if (IN_BF16) { const bf16_t* sp = (const bf16_t*)src + (size_t)row * DM;
#pragma unroll
        for (int i = 0; i < 4; ++i) raw.r[i] = *(const u32x4*)(sp + (i * 64 + lane) * 8);
    } else { const float* sp = (const float*)src + (size_t)row * DM;
#pragma unroll
        for (int i = 0; i < 8; ++i) raw.r[i] = *(const u32x4*)(sp + (i * 64 + lane) * 4); }
}
template <bool IN_BF16, bool OUT_F32>
__device__ __forceinline__ void ln_rows(const void* src, const float* gam, const float* bet, void* dst, int nrows) {
    int tid = threadIdx.x; asm volatile("" : "+v"(tid));
    const int lane = tid & 63, w = tid >> 6, stride = gridDim.x * 8;
    int row = blockIdx.x * 8 + w;
    LnRaw<IN_BF16> raw;
    if (row < nrows) ln_load<IN_BF16>(src, row, lane, raw);
    for (; row < nrows; row += stride) {
        f32x4 v[8]; float s = 0.f;
        if (IN_BF16) {
#pragma unroll
            for (int i = 0; i < 4; ++i) { const u32x4 a = raw.r[i];
                v[2 * i] = (f32x4){bf_lo(a.x), bf_hi(a.x), bf_lo(a.y), bf_hi(a.y)}; v[2 * i + 1] = (f32x4){bf_lo(a.z), bf_hi(a.z), bf_lo(a.w), bf_hi(a.w)}; }
        } else {
#pragma unroll
            for (int i = 0; i < 8; ++i) v[i] = __builtin_bit_cast(f32x4, raw.r[i]); }
        if (row + stride < nrows) ln_load<IN_BF16>(src, row + stride, lane, raw);
#pragma unroll
        for (int i = 0; i < 8; ++i) s += (v[i][0] + v[i][1]) + (v[i][2] + v[i][3]);
        s = wave_sum(s); const float mu = s * (1.0f / DM); float q = 0.f;
#pragma unroll
        for (int i = 0; i < 8; ++i) { v[i] = v[i] - mu; q += (v[i][0] * v[i][0] + v[i][1] * v[i][1]) + (v[i][2] * v[i][2] + v[i][3] * v[i][3]); }
        q = wave_sum(q); const float rstd = 1.0f / sqrtf(q * (1.0f / DM) + LN_EPS);
#pragma unroll
        for (int i = 0; i < 8; ++i) { const int col = IN_BF16 ? ((i >> 1) * 64 + lane) * 8 + (i & 1) * 4 : (i * 64 + lane) * 4;
            const f32x4 y = v[i] * rstd * *(const f32x4*)(gam + col) + *(const f32x4*)(bet + col);
            if (OUT_F32) *(f32x4*)((float*)dst + (size_t)row * DM + col) = y;
            else { u32x2 o; o.x = cvt_pk_bf16(y[0], y[1]); o.y = cvt_pk_bf16(y[2], y[3]); *(u32x2*)((bf16_t*)dst + (size_t)row * DM + col) = o; } }
    }
}
struct TrJob { const float* src; int ld, k0, col0; bf16_t* dst; int ldd, n0; float scale; };
__device__ __forceinline__ void tr_load(const TrJob& j, f32x4 (&v)[2]) {
    const int tid = threadIdx.x;
#pragma unroll
    for (int p = 0; p < 2; ++p) { const int row = (tid >> 4) + 32 * p, c4 = (tid & 15) * 4; v[p] = *(const f32x4*)(j.src + (size_t)(j.k0 + row) * j.ld + j.col0 + c4); }
}
__device__ __forceinline__ void tr_put(const f32x4 (&v)[2], LAS float* tile) {
    const int tid = threadIdx.x;
#pragma unroll
    for (int p = 0; p < 2; ++p) { const int row = (tid >> 4) + 32 * p, c4 = (tid & 15) * 4;
        tile[row * 65 + c4 + 0] = v[p][0]; tile[row * 65 + c4 + 1] = v[p][1]; tile[row * 65 + c4 + 2] = v[p][2]; tile[row * 65 + c4 + 3] = v[p][3]; }
}
__device__ __forceinline__ void tr_get(const TrJob& j, LAS float* tile) {
    const int tid = threadIdx.x, n = tid >> 3, k8 = (tid & 7) * 8; float f[8];
#pragma unroll
    for (int i = 0; i < 8; ++i) f[i] = tile[(k8 + i) * 65 + n] * j.scale;
    u32x4 w; w.x = cvt_pk_bf16(f[0], f[1]); w.y = cvt_pk_bf16(f[2], f[3]); w.z = cvt_pk_bf16(f[4], f[5]); w.w = cvt_pk_bf16(f[6], f[7]);
    *(u32x4*)(j.dst + (size_t)(j.n0 + n) * j.ldd + j.k0 + k8) = w;
}
__device__ __forceinline__ TrJob tr_job(const Params& P, int id) {
    unsigned char* ws = P.ws; TrJob j; j.scale = 1.0f;
    constexpr int N_IN = 32 * 80, N_SQ = 32 * 32, N_GU = 32 * 176;
    int t = id;
    if (t < N_IN) { const int nt = t % 80, kt = t / 80; int col0 = nt * 64;
        if (nt < 32) { const int t256 = nt >> 2, sub = nt & 3; col0 = t256 * 256 + ((sub & 1) ? 128 : 0) + 64 * (sub >> 1); }
        j.src = P.w_in; j.ld = NIN; j.k0 = kt * 64; j.col0 = col0; j.dst = (bf16_t*)(ws + WS_WIN); j.ldd = DM; j.n0 = nt * 64; return j; }
    t -= N_IN;
    if (t < 4 * N_SQ) { const int wsel = t / N_SQ, r = t % N_SQ, nt = r % 32, kt = r / 32;
        j.src = wsel == 0 ? P.w_mix : wsel == 1 ? P.w_xk : wsel == 2 ? P.w_xv : P.w_xo;
        j.dst = (bf16_t*)(ws + WS_WMIX) + (size_t)(wsel == 0 ? 0 : wsel + 1) * ((size_t)DM * DM);
        j.ld = DM; j.k0 = kt * 64; j.col0 = nt * 64; j.ldd = DM; j.n0 = nt * 64; return j; }
    t -= 4 * N_SQ;
    if (t < N_GU) { const int nt = t % 176, kt = t / 176, t256 = nt >> 2, sub = nt & 3;
        j.src = (sub < 2) ? P.w_gate : P.w_up; j.ld = DFF; j.k0 = kt * 64; j.col0 = t256 * 128 + (sub & 1) * 64; j.dst = (bf16_t*)(ws + WS_WGU); j.ldd = DM; j.n0 = nt * 64;
        j.scale = (sub < 2) ? -1.4426950408889634f : -0.6931471805599453f;
        return j; }
    t -= N_GU;
    { const int nt = t % 32, kt = t / 32; j.src = P.w_down; j.ld = DM; j.k0 = kt * 64; j.col0 = nt * 64; j.dst = (bf16_t*)(ws + WS_WDN); j.ldd = DFF; j.n0 = nt * 64; }
    return j;
}

__device__ __forceinline__ void prep_phase(const Params& P, LAS unsigned char* lds) {
    unsigned char* ws = P.ws; const int tid = threadIdx.x, G = gridDim.x;
    LAS float* tile = (LAS float*)lds;
    constexpr int N_ALL = 32 * 80 + 4 * 32 * 32 + 32 * 176 + 88 * 32;
    { int id = blockIdx.x; f32x4 v[2]; TrJob cur;
      if (id < N_ALL) { cur = tr_job(P, id); tr_load(cur, v); }
      int par = 0;
      while (id < N_ALL) {
          LAS float* tl = tile + par * (64 * 65);
          tr_put(v, tl);
          const int nid = id + G; TrJob nxt = cur;
          if (nid < N_ALL) { nxt = tr_job(P, nid); tr_load(nxt, v); }
          __syncthreads();
          tr_get(cur, tl);
          cur = nxt; id = nid; par ^= 1;
      }
      __syncthreads(); }
    ln_rows<false, false>(P.x, P.ln_in_g, P.ln_in_b, ws + WS_R0, T);
    const size_t gtid = (size_t)blockIdx.x * 512 + tid, gsz = (size_t)G * 512;
    for (size_t i = gtid; i < (size_t)DM * DM / 4; i += gsz) { const f32x4 v = *(const f32x4*)(P.w_xq + i * 4); u32x2 o; o.x = cvt_pk_bf16(v[0], v[1]); o.y = cvt_pk_bf16(v[2], v[3]); *(u32x2*)((bf16_t*)(ws + WS_WXQ) + i * 4) = o; }
    for (size_t i = gtid; i < (size_t)NB * MEMLEN * DM / 4; i += gsz) { const f32x4 v = *(const f32x4*)(P.mem + i * 4); u32x2 o; o.x = cvt_pk_bf16(v[0], v[1]); o.y = cvt_pk_bf16(v[2], v[3]); *(u32x2*)((bf16_t*)(ws + WS_MEMB) + i * 4) = o; }
    for (size_t i = gtid; i < (size_t)8 * 128 * 128; i += gsz) { const int j = (int)(i & 127), ii = (int)((i >> 7) & 127); const float v = (j <= ii) ? P.w_sp[i] : 0.f; ((bf16_t*)(ws + WS_WSP))[i] = (bf16_t)(cvt_pk_bf16(v, 0.f) & 0xffffu); }
    const double th_own = exp(-(double)(int)(gtid & 63) * (9.210340371976184 / 64.0));
    for (size_t i = gtid; i < (size_t)T * 64; i += gsz) { const int tok = (int)(i >> 6);
        const double th = ((gsz & 63) == 0) ? th_own : exp(-(double)(int)(i & 63) * (9.210340371976184 / 64.0)); const double a = (double)P.pos[tok] * th;
        const double qd = rint(a * 0.6366197723675814); double r = fma(-qd, 1.5707963267948966, a); r = fma(-qd, 6.123233995736766e-17, r);
        const int qi = ((int)(long long)qd) & 3; const double r2 = r * r;
        const double sn = r * (1.0 + r2 * (-1.0 / 6 + r2 * (1.0 / 120 + r2 * (-1.0 / 5040 + r2 * (1.0 / 362880 + r2 * (-1.0 / 39916800))))));
        const double cs = 1.0 + r2 * (-0.5 + r2 * (1.0 / 24 + r2 * (-1.0 / 720 + r2 * (1.0 / 40320 + r2 * (-1.0 / 3628800 + r2 * (1.0 / 479001600))))));
        double c, s; if (qi == 0) { c = cs; s = sn; } else if (qi == 1) { c = -sn; s = cs; } else if (qi == 2) { c = -cs; s = -sn; } else { c = sn; s = -cs; }
        *(f32x2*)((float*)(ws + WS_ROPE) + i * 2) = (f32x2){(float)c, (float)s}; }
}

struct AttnProb { int br, d, blk, h, base_tok; };
__device__ __forceinline__ AttnProb attn_decode(int p) {
    AttnProb a; a.br = p >> 11; const int rem = p & 2047, dl = a.br * 2, nb = 128 >> dl; a.d = 1 << dl;
    a.blk = rem & (nb - 1); int t = rem >> (7 - dl); const int r = t & (a.d - 1); t >>= dl; a.h = t & 7; a.base_tok = (t >> 3) * SEQ + r; return a;
}
__device__ __forceinline__ void attn_phase(const Params& P, LAS unsigned char* lds) {
    unsigned char* ws = P.ws;
    const bf16_t* qb = (const bf16_t*)(ws + WS_R1); const bf16_t* kb = qb + (size_t)T * 1024; const bf16_t* vb = kb + (size_t)T * 1024;
    bf16_t* obr = (bf16_t*)(ws + WS_R2); float* lse = (float*)(ws + WS_LSE);
    int tid = threadIdx.x; asm volatile("" : "+v"(tid));
    const int lane = tid & 63, w = __builtin_amdgcn_readfirstlane(tid >> 6), n = lane & 15, g = lane >> 4;
    LAS unsigned char* Kimg = lds; LAS unsigned char* Vimg = lds + 65536;
    const int G = gridDim.x; int p0, pend;
    if (G == 256) { const int cb = blockIdx.x; const bool gw = (cb < 16) || (cb >= 128 && cb < 144);
        const int ng = cb < 16 ? cb : (cb < 128 ? 16 : (cb < 144 ? 16 + (cb - 128) : 32));
        p0 = ng * 17 + (cb - ng) * 25; pend = p0 + (gw ? 17 : 25); }
    else { const int ppw = (6144 + G - 1) / G; p0 = blockIdx.x * ppw; pend = p0 + ppw; }
    if (pend > 6144) pend = 6144;
    if (p0 >= pend) return;
    const int kt0 = 2 * (w >> 1), iq = 16 * w + n;
    const unsigned trq = (unsigned)(n >> 2), trp = (unsigned)(n & 3);
    const int srow = tid >> 4, sch = tid & 15;
    u32x4 pk[4], pv[4]; bf16x8 qf[4];
    AttnProb cur = attn_decode(p0);
#define ATT_LOAD_TILE(pr, blkidx) do { _Pragma("unroll") for (int i = 0; i < 4; ++i) { const int j = (blkidx) * 128 + srow + 32 * i; \
        const size_t o = ((size_t)(pr).h * T + (pr).base_tok + j * (pr).d) * 128 + sch * 8; pk[i] = *(const u32x4*)(kb + o); pv[i] = *(const u32x4*)(vb + o); } } while (0)
#define ATT_PUT_TILE(slot) do { _Pragma("unroll") for (int i = 0; i < 4; ++i) { const unsigned row = (unsigned)(srow + 32 * i); \
        const unsigned prow = (row & ~31u) | (((row >> 2) & 3u) << 3) | (((row >> 4) & 1u) << 2) | (row & 3u); \
        *(LAS u32x4*)(Kimg + off_b((unsigned)(slot) * 128u + row, (unsigned)sch)) = pk[i]; *(LAS u32x4*)(Vimg + off_b((unsigned)(slot) * 128u + prow, (unsigned)sch)) = pv[i]; } } while (0)
#define ATT_LOAD_Q(pr) do { const int tq_ = (pr).base_tok + ((pr).blk * 128 + iq) * (pr).d; _Pragma("unroll") for (int s_ = 0; s_ < 4; ++s_) qf[s_] = *(const bf16x8*)(qb + ((size_t)(pr).h * T + tq_) * 128 + 32 * s_ + 8 * g); } while (0)
    if (cur.blk > 0) { ATT_LOAD_TILE(cur, cur.blk - 1); } else {
#pragma unroll
        for (int i = 0; i < 4; ++i) { pk[i] = (u32x4){0u, 0u, 0u, 0u}; pv[i] = (u32x4){0u, 0u, 0u, 0u}; } }
    ATT_PUT_TILE((cur.blk & 1) ^ 1);
    ATT_LOAD_TILE(cur, cur.blk);
    ATT_PUT_TILE(cur.blk & 1);
    ATT_LOAD_Q(cur);
    __syncthreads();
    for (int p = p0; p < pend; ++p) {
        const int sc = cur.blk & 1, blk = cur.blk;
        const int tq = cur.base_tok + (blk * 128 + iq) * cur.d;
        f32x4 sacc[10]; bf16x8 kfr[2][4]; float mx = -3.0e38f;
#define ATT_LDK(i_, buf_) do { const int kt_ = kt0 + (i_); const unsigned prow_ = (unsigned)(((sc ^ ((kt_ >> 3) ^ 1)) << 7) | ((16 * kt_ + n) & 127)); \
        _Pragma("unroll") for (int s_ = 0; s_ < 4; ++s_) kfr[buf_][s_] = *(const LAS bf16x8*)(Kimg + off_b(prow_, (unsigned)(4 * s_ + g))); } while (0)
#define ATT_MASK(i_) do { if ((i_) < 2 || (i_) > 7) { _Pragma("unroll") for (int e = 0; e < 4; ++e) { const int kpos = 16 * (kt0 + (i_)) + 4 * g + e; \
                const bool valid = (kpos >= iq) && (kpos <= iq + 128) && (blk > 0 || kpos >= 128); const float sc2 = valid ? sacc[i_][e] : -3.0e38f; sacc[i_][e] = sc2; mx = fmaxf(mx, sc2); } } \
            else { const bool tile_ok = (blk > 0) || (kt0 + (i_) >= 8); _Pragma("unroll") for (int e = 0; e < 4; ++e) { const float sc2 = tile_ok ? sacc[i_][e] : -3.0e38f; sacc[i_][e] = sc2; mx = fmaxf(mx, sc2); } } } while (0)
        ATT_LDK(0, 0);
#pragma unroll
        for (int i = 0; i < 10; ++i) { sacc[i] = (f32x4){0.f, 0.f, 0.f, 0.f};
            if (i < 9) ATT_LDK(i + 1, (i + 1) & 1);
            __builtin_amdgcn_sched_barrier(0);
#pragma unroll
            for (int s = 0; s < 4; ++s) sacc[i] = __builtin_amdgcn_mfma_f32_16x16x32_bf16(kfr[i & 1][s], qf[s], sacc[i], 0, 0, 0);
            if (i > 0) ATT_MASK(i - 1);
            __builtin_amdgcn_sched_barrier(0); }
        ATT_MASK(9);
#undef ATT_LDK
#undef ATT_MASK
        const bool has_next = (p + 1 < pend);
        AttnProb nxt = cur;
        if (has_next) { nxt = attn_decode(p + 1); ATT_LOAD_TILE(nxt, nxt.blk); ATT_LOAD_Q(nxt); }
        mx = fmaxf(mx, __shfl_xor(mx, 16)); mx = fmaxf(mx, __shfl_xor(mx, 32));
        float l = 0.f; bf16x8 pb; s16x4 tl[8][2]; f32x4 oacc[8];
#define ATT_EXP(k_) do { u32x4 wv_; float pe_[8]; _Pragma("unroll") for (int e = 0; e < 4; ++e) { pe_[e] = __builtin_amdgcn_exp2f(sacc[2 * (k_)][e] - mx); pe_[4 + e] = __builtin_amdgcn_exp2f(sacc[2 * (k_) + 1][e] - mx); } \
            l += ((pe_[0] + pe_[1]) + (pe_[2] + pe_[3])) + ((pe_[4] + pe_[5]) + (pe_[6] + pe_[7])); \
            wv_.x = cvt_pk_bf16(pe_[0], pe_[1]); wv_.y = cvt_pk_bf16(pe_[2], pe_[3]); wv_.z = cvt_pk_bf16(pe_[4], pe_[5]); wv_.w = cvt_pk_bf16(pe_[6], pe_[7]); pb = __builtin_bit_cast(bf16x8, wv_); } while (0)
#define ATT_LDV(k_) do { const int ks_ = (kt0 >> 1) + (k_); const unsigned rb_ = (unsigned)(((sc ^ ((ks_ >> 2) ^ 1)) << 7) | (32 * (ks_ & 3))) + 8u * g + trq; \
            _Pragma("unroll") for (int c_ = 0; c_ < 8; ++c_) { \
            tl[c_][0] = __builtin_amdgcn_ds_read_tr16_b64_v4i16((LAS s16x4*)(Vimg + off_b(rb_, 2u * c_ + (trp >> 1)) + 8u * (trp & 1))); \
            tl[c_][1] = __builtin_amdgcn_ds_read_tr16_b64_v4i16((LAS s16x4*)(Vimg + off_b(rb_ + 4u, 2u * c_ + (trp >> 1)) + 8u * (trp & 1))); } } while (0)
#pragma unroll
        for (int c = 0; c < 8; ++c) oacc[c] = (f32x4){0.f, 0.f, 0.f, 0.f};
#pragma unroll
        for (int k = 0; k < 5; ++k) {
            ATT_LDV(k);
            ATT_EXP(k);
#pragma unroll
            for (int c = 0; c < 8; ++c) { const s16x4 lo = tl[c][0], hi = tl[c][1];
                const bf16x8 vf = (bf16x8){lo[0], lo[1], lo[2], lo[3], hi[0], hi[1], hi[2], hi[3]};
                oacc[c] = __builtin_amdgcn_mfma_f32_16x16x32_bf16(vf, pb, oacc[c], 0, 0, 0); }
            __builtin_amdgcn_sched_barrier(0); }
#undef ATT_EXP
#undef ATT_LDV
        l += __shfl_xor(l, 16); l += __shfl_xor(l, 32);
        const float inv = 1.0f / l;
        { LAS unsigned char* stg = lds + pg8::STAGE_BYTES + w * 2304;
#pragma unroll
          for (int half = 0; half < 2; ++half) {
#pragma unroll
              for (int cc = 0; cc < 4; ++cc) { const int c = half * 4 + cc; u32x2 o; o.x = cvt_pk_bf16(oacc[c][0] * inv, oacc[c][1] * inv); o.y = cvt_pk_bf16(oacc[c][2] * inv, oacc[c][3] * inv);
                  *(LAS u32x2*)(stg + n * 144 + (16 * cc + 4 * g) * 2) = o; }
#pragma unroll
              for (int i = 0; i < 2; ++i) { const int rw = (lane >> 3) + 8 * i, chunk = lane & 7; const u32x4 v = *(const LAS u32x4*)(stg + rw * 144 + chunk * 16);
                  const int tqr = cur.base_tok + (blk * 128 + 16 * w + rw) * cur.d;
                  *(u32x4*)(obr + ((size_t)cur.br * T + tqr) * 1024 + cur.h * 128 + half * 64 + chunk * 8) = v; } } }
        if (g == 0) lse[((size_t)cur.br * T + tq) * 8 + cur.h] = (mx + __builtin_amdgcn_logf(l)) * 0.6931471805599453f;
        __syncthreads();
        if (has_next) {
            ATT_PUT_TILE(nxt.blk & 1);
            if (nxt.blk == 0) {
#pragma unroll
                for (int i = 0; i < 4; ++i) { pk[i] = (u32x4){0u, 0u, 0u, 0u}; pv[i] = (u32x4){0u, 0u, 0u, 0u}; }
                ATT_PUT_TILE(1); }
        }
        __syncthreads();
        cur = nxt;
    }
#undef ATT_LOAD_TILE
#undef ATT_PUT_TILE
#undef ATT_LOAD_Q
}

__device__ __forceinline__ void unpack16(const u32x4 a, const u32x4 b, float (&f)[16]) {
    f[0] = bf_lo(a.x); f[1] = bf_hi(a.x); f[2] = bf_lo(a.y); f[3] = bf_hi(a.y); f[4] = bf_lo(a.z); f[5] = bf_hi(a.z); f[6] = bf_lo(a.w); f[7] = bf_hi(a.w);
    f[8] = bf_lo(b.x); f[9] = bf_hi(b.x); f[10] = bf_lo(b.y); f[11] = bf_hi(b.y); f[12] = bf_lo(b.z); f[13] = bf_hi(b.z); f[14] = bf_lo(b.w); f[15] = bf_hi(b.w);
}
__device__ __forceinline__ void gating_phase(const Params& P, LAS unsigned char* lds) {
    unsigned char* ws = P.ws;
    const bf16_t* ub = (const bf16_t*)(ws + WS_R1) + (size_t)3 * T * 1024; const bf16_t* gb = ub + (size_t)T * 1024;
    bf16_t* A2 = (bf16_t*)(ws + WS_R3); const bf16_t* wsp = (const bf16_t*)(ws + WS_WSP);
    int tid = threadIdx.x; asm volatile("" : "+v"(tid));
    const int lane = tid & 63, w = __builtin_amdgcn_readfirstlane(tid >> 6), n = lane & 15, g = lane >> 4;
    LAS float* stat = (LAS float*)(lds + 65536);
    const unsigned trq = (unsigned)(n >> 2), trp = (unsigned)(n & 3);
    const int srow = tid >> 4, sch = tid & 15;
    for (int chunk = blockIdx.x; chunk < T / 128; chunk += gridDim.x) {
        const int tok0 = chunk * 128;
#pragma unroll
        for (int bt = 0; bt < 2; ++bt) { u32x4 ra[8], rb[8];
#pragma unroll
            for (int rr = 0; rr < 8; ++rr) { const bf16_t* gp = gb + ((size_t)(lane >> 3) * T + tok0 + 16 * w + bt * 8 + rr) * 128 + (lane & 7) * 16; ra[rr] = *(const u32x4*)gp; rb[rr] = *(const u32x4*)(gp + 8); }
#pragma unroll
            for (int rr = 0; rr < 8; ++rr) { float f[16]; unpack16(ra[rr], rb[rr], f); float s = 0.f;
#pragma unroll
                for (int j = 0; j < 16; ++j) s += f[j];
                s = wave_sum(s); const float mu = s * (1.0f / 1024.0f); float q = 0.f;
#pragma unroll
                for (int j = 0; j < 16; ++j) { const float dd = f[j] - mu; q += dd * dd; }
                q = wave_sum(q);
                if (lane == 0) { const int row = 16 * w + bt * 8 + rr; stat[row * 2] = mu; stat[row * 2 + 1] = 1.0f / sqrtf(q * (1.0f / 1024.0f) + LN_EPS); } } }
        u32x4 traw[4];
#pragma unroll
        for (int i = 0; i < 4; ++i) traw[i] = *(const u32x4*)(gb + (size_t)(tok0 + srow + 32 * i) * 128 + sch * 8);
        __syncthreads();
        const int pos = 16 * w + n, tok = tok0 + pos, nks = (w >> 1) + 1;
        for (int gi = 0; gi < 8; ++gi) {
            LAS unsigned char* img = lds + (gi & 1) * 32768;
            { const int c0 = gi * 128 + sch * 8;
              const f32x4 g0 = *(const f32x4*)(P.sgu_g + c0), g1 = *(const f32x4*)(P.sgu_g + c0 + 4), b0 = *(const f32x4*)(P.sgu_b + c0), b1 = *(const f32x4*)(P.sgu_b + c0 + 4);
#pragma unroll
              for (int i = 0; i < 4; ++i) { const int row = srow + 32 * i; const u32x4 a = traw[i]; const float mu = stat[row * 2], rs = stat[row * 2 + 1];
                const f32x4 x0 = (f32x4){bf_lo(a.x), bf_hi(a.x), bf_lo(a.y), bf_hi(a.y)}, x1 = (f32x4){bf_lo(a.z), bf_hi(a.z), bf_lo(a.w), bf_hi(a.w)};
                *(LAS u32x4*)(img + off_b((unsigned)row, (unsigned)sch)) = pack8((x0 - mu) * rs * g0 + b0, (x1 - mu) * rs * g1 + b1); } }
            if (gi < 7) {
#pragma unroll
                for (int i = 0; i < 4; ++i) traw[i] = *(const u32x4*)(gb + ((size_t)(gi + 1) * T + tok0 + srow + 32 * i) * 128 + sch * 8); }
            bf16x8 wf[4]; u32x2 uv[8];
#pragma unroll
            for (int ks = 0; ks < 4; ++ks) wf[ks] = (ks < nks) ? *(const bf16x8*)(wsp + (size_t)(gi * 128 + pos) * 128 + 32 * ks + 8 * g) : (bf16x8){0, 0, 0, 0, 0, 0, 0, 0};
#pragma unroll
            for (int c = 0; c < 8; ++c) uv[c] = *(const u32x2*)(ub + ((size_t)gi * T + tok) * 128 + 16 * c + 4 * g);
            const float bs = P.b_sp[gi * 128 + pos];
            __syncthreads();
            s16x4 tg[2][4][2];
#define GAT_LD(c_, buf_) do { _Pragma("unroll") for (int ks_ = 0; ks_ < 4; ++ks_) if (ks_ < nks) { \
                tg[buf_][ks_][0] = __builtin_amdgcn_ds_read_tr16_b64_v4i16((LAS s16x4*)(img + off_b(32u * ks_ + 8u * g + trq, 2u * (c_) + (trp >> 1)) + 8u * (trp & 1))); \
                tg[buf_][ks_][1] = __builtin_amdgcn_ds_read_tr16_b64_v4i16((LAS s16x4*)(img + off_b(32u * ks_ + 8u * g + 4u + trq, 2u * (c_) + (trp >> 1)) + 8u * (trp & 1))); } } while (0)
            GAT_LD(0, 0);
#pragma unroll
            for (int c = 0; c < 8; ++c) { f32x4 acc = (f32x4){0.f, 0.f, 0.f, 0.f};
                if (c < 7) GAT_LD(c + 1, (c + 1) & 1);
                __builtin_amdgcn_sched_barrier(0);
#pragma unroll
                for (int ks = 0; ks < 4; ++ks) if (ks < nks) { const s16x4 lo = tg[c & 1][ks][0], hi = tg[c & 1][ks][1];
                    const bf16x8 vf = (bf16x8){lo[0], lo[1], lo[2], lo[3], hi[0], hi[1], hi[2], hi[3]};
                    acc = __builtin_amdgcn_mfma_f32_16x16x32_bf16(vf, wf[ks], acc, 0, 0, 0); }
                u32x2 o; o.x = cvt_pk_bf16(bf_lo(uv[c].x) * (acc[0] + bs), bf_hi(uv[c].x) * (acc[1] + bs)); o.y = cvt_pk_bf16(bf_lo(uv[c].y) * (acc[2] + bs), bf_hi(uv[c].y) * (acc[3] + bs));
                *(u32x2*)(A2 + (size_t)tok * 2048 + 1024 + gi * 128 + 16 * c + 4 * g) = o;
                __builtin_amdgcn_sched_barrier(0); }
#undef GAT_LD
        }
        __syncthreads();
    }
}

struct MergeRaw { u32x4 a[3], b[3], ga, gbq; float l[3]; };
__device__ __forceinline__ void merge_load(const bf16_t* obr, const float* lse, const bf16_t* A2, int tok, int h, int c0, MergeRaw& m) {
#pragma unroll
    for (int r = 0; r < 3; ++r) { const bf16_t* sp = obr + ((size_t)r * T + tok) * 1024 + c0; m.a[r] = *(const u32x4*)sp; m.b[r] = *(const u32x4*)(sp + 8); m.l[r] = lse[((size_t)r * T + tok) * 8 + h]; }
    const bf16_t* gp = A2 + (size_t)tok * 2048 + 1024 + c0; m.ga = *(const u32x4*)gp; m.gbq = *(const u32x4*)(gp + 8);
}
__device__ __forceinline__ void merge_phase(const Params& P) {
    unsigned char* ws = P.ws; const bf16_t* obr = (const bf16_t*)(ws + WS_R2); const float* lse = (const float*)(ws + WS_LSE); bf16_t* A2 = (bf16_t*)(ws + WS_R3);
    int tid = threadIdx.x; asm volatile("" : "+v"(tid));
    const int lane = tid & 63, w = tid >> 6, h = lane >> 3, c0 = lane * 16, stride = gridDim.x * 8;
    f32x4 ga[4], gg[4];
#pragma unroll
    for (int i = 0; i < 4; ++i) { ga[i] = *(const f32x4*)(P.attn_g + c0 + 4 * i); gg[i] = *(const f32x4*)(P.gmlp_g + c0 + 4 * i); }
    int tok = blockIdx.x * 8 + w, tend = T, tstep = stride; MergeRaw m;
    if (gridDim.x == 256) { const int cb = blockIdx.x; const bool gw = (cb < 64) || (cb >= 128 && cb < 192);
        const int ng = cb < 64 ? cb : (cb < 128 ? 64 : (cb < 192 ? 64 + (cb - 128) : 128)); const int start = ng * 112 + (cb - ng) * 144;
        tok = start + w; tend = start + (gw ? 112 : 144); tstep = 8; }
    if (tok < tend) merge_load(obr, lse, A2, tok, h, c0, m);
    for (; tok < tend; tok += tstep) {
        float l0 = m.l[0], l1 = m.l[1], l2 = m.l[2];
        const float mm = fmaxf(l0, fmaxf(l1, l2)); l0 = __expf(l0 - mm); l1 = __expf(l1 - mm); l2 = __expf(l2 - mm);
        const float inv = 1.0f / (l0 + l1 + l2); const float wt[3] = {l0 * inv, l1 * inv, l2 * inv};
        float o[16], x[16];
#pragma unroll
        for (int j = 0; j < 16; ++j) o[j] = 0.f;
#pragma unroll
        for (int r = 0; r < 3; ++r) { float f[16]; unpack16(m.a[r], m.b[r], f);
#pragma unroll
            for (int j = 0; j < 16; ++j) o[j] += wt[r] * f[j]; }
        unpack16(m.ga, m.gbq, x);
        if (tok + tstep < tend) merge_load(obr, lse, A2, tok + tstep, h, c0, m);
        float ss = 0.f, sg = 0.f;
#pragma unroll
        for (int j = 0; j < 16; ++j) { ss += o[j] * o[j]; sg += x[j] * x[j]; }
        ss = wave_sum(ss); sg = wave_sum(sg);
        const float rs = 1.0f / sqrtf(ss * (1.0f / 1024.0f) + LN_EPS), rg = 1.0f / sqrtf(sg * (1.0f / 1024.0f) + LN_EPS);
        bf16_t* dp = A2 + (size_t)tok * 2048 + c0;
        { u32x4 w0, w1; w0.x = cvt_pk_bf16(o[0] * rs * ga[0][0], o[1] * rs * ga[0][1]); w0.y = cvt_pk_bf16(o[2] * rs * ga[0][2], o[3] * rs * ga[0][3]); w0.z = cvt_pk_bf16(o[4] * rs * ga[1][0], o[5] * rs * ga[1][1]); w0.w = cvt_pk_bf16(o[6] * rs * ga[1][2], o[7] * rs * ga[1][3]);
          w1.x = cvt_pk_bf16(o[8] * rs * ga[2][0], o[9] * rs * ga[2][1]); w1.y = cvt_pk_bf16(o[10] * rs * ga[2][2], o[11] * rs * ga[2][3]); w1.z = cvt_pk_bf16(o[12] * rs * ga[3][0], o[13] * rs * ga[3][1]); w1.w = cvt_pk_bf16(o[14] * rs * ga[3][2], o[15] * rs * ga[3][3]);
          *(u32x4*)dp = w0; *(u32x4*)(dp + 8) = w1; }
        { u32x4 w0, w1; w0.x = cvt_pk_bf16(x[0] * rg * gg[0][0], x[1] * rg * gg[0][1]); w0.y = cvt_pk_bf16(x[2] * rg * gg[0][2], x[3] * rg * gg[0][3]); w0.z = cvt_pk_bf16(x[4] * rg * gg[1][0], x[5] * rg * gg[1][1]); w0.w = cvt_pk_bf16(x[6] * rg * gg[1][2], x[7] * rg * gg[1][3]);
          w1.x = cvt_pk_bf16(x[8] * rg * gg[2][0], x[9] * rg * gg[2][1]); w1.y = cvt_pk_bf16(x[10] * rg * gg[2][2], x[11] * rg * gg[2][3]); w1.z = cvt_pk_bf16(x[12] * rg * gg[3][0], x[13] * rg * gg[3][1]); w1.w = cvt_pk_bf16(x[14] * rg * gg[3][2], x[15] * rg * gg[3][3]);
          *(u32x4*)(dp + 1024) = w0; *(u32x4*)(dp + 1032) = w1; }
    }
}

struct GridBar { unsigned* xarr; unsigned* top; unsigned nx, nxcd, epoch; };
__device__ __forceinline__ unsigned xcc_id() { return (unsigned)__builtin_amdgcn_s_getreg((3 << 11) | 20) & 0xFu; }
__device__ __forceinline__ void grid_bar(GridBar& b) {
    asm volatile("s_waitcnt vmcnt(0) lgkmcnt(0)" ::: "memory");
    __syncthreads();
    b.epoch += 1;
    if (threadIdx.x == 0) {
        const unsigned old = __hip_atomic_fetch_add(b.xarr, 1u, __ATOMIC_RELAXED, __HIP_MEMORY_SCOPE_AGENT);
        if (old + 1 == b.epoch * b.nx) {
            __builtin_amdgcn_fence(__ATOMIC_RELEASE, "agent");
            asm volatile("s_waitcnt vmcnt(0)" ::: "memory");
            __hip_atomic_fetch_add(b.top, 1u, __ATOMIC_RELAXED, __HIP_MEMORY_SCOPE_AGENT);
        }
        const unsigned want = b.epoch * b.nxcd;
        while (__hip_atomic_load(b.top, __ATOMIC_RELAXED, __HIP_MEMORY_SCOPE_AGENT) < want) __builtin_amdgcn_s_sleep(2);
        __builtin_amdgcn_fence(__ATOMIC_ACQUIRE, "agent");
        asm volatile("s_waitcnt vmcnt(0)" ::: "memory");
    }
    asm volatile("" ::: "memory"); __syncthreads(); asm volatile("" ::: "memory");
}

constexpr int LDS_BYTES = pg8::STAGE_BYTES + 18432;

__global__ void __launch_bounds__(512) mega_fwd(Params P) {
    extern __shared__ __attribute__((aligned(16))) unsigned char lds_raw[];
    LAS unsigned char* lds = (LAS unsigned char*)lds_raw;
    cg::grid_group grid = cg::this_grid();
    unsigned char* ws = P.ws; const int G = gridDim.x, c = blockIdx.x;
    bf16_t* const WIN = (bf16_t*)(ws + WS_WIN); bf16_t* const WMIX = (bf16_t*)(ws + WS_WMIX); bf16_t* const WXQ = (bf16_t*)(ws + WS_WXQ); bf16_t* const WXK = (bf16_t*)(ws + WS_WXK);
    bf16_t* const WXV = (bf16_t*)(ws + WS_WXV); bf16_t* const WXO = (bf16_t*)(ws + WS_WXO); bf16_t* const WGU = (bf16_t*)(ws + WS_WGU); bf16_t* const WDN = (bf16_t*)(ws + WS_WDN);
    bf16_t* const h0 = (bf16_t*)(ws + WS_R0); bf16_t* const act = (bf16_t*)(ws + WS_R0);
    bf16_t* const qb = (bf16_t*)(ws + WS_R1); bf16_t* const y12 = (bf16_t*)(ws + WS_R1); bf16_t* const y3 = (bf16_t*)(ws + WS_R2); bf16_t* const Pm = (bf16_t*)(ws + WS_R1 + 256 * MiB);
    bf16_t* const h1 = (bf16_t*)(ws + WS_R2); bf16_t* const A2 = (bf16_t*)(ws + WS_R3); bf16_t* const h2 = (bf16_t*)(ws + WS_R3);
    bf16_t* const memb = (bf16_t*)(ws + WS_MEMB); bf16_t* const kx = (bf16_t*)(ws + WS_KX); bf16_t* const vx = (bf16_t*)(ws + WS_VT); bf16_t* const Wqk = (bf16_t*)(ws + WS_WQK); bf16_t* const VWo = (bf16_t*)(ws + WS_VWO);

    if (threadIdx.x == 0) __hip_atomic_fetch_add((unsigned*)(ws + WS_BAR) + 64 * xcc_id(), 1u, __ATOMIC_RELAXED, __HIP_MEMORY_SCOPE_AGENT);
    prep_phase(P, lds);
    if (PROBE_MASK & 1) { grid.sync(); prep_phase(P, lds); }
    grid.sync();
    GridBar gb;
    { unsigned* const bw = (unsigned*)(ws + WS_BAR); const unsigned x = xcc_id(); unsigned n = 0;
      for (int j = 0; j < 16; ++j) n += (__hip_atomic_load(bw + 64 * j, __ATOMIC_RELAXED, __HIP_MEMORY_SCOPE_AGENT) != 0u) ? 1u : 0u;
      gb.nx = __hip_atomic_load(bw + 64 * x, __ATOMIC_RELAXED, __HIP_MEMORY_SCOPE_AGENT); gb.nxcd = n; gb.xarr = bw + 64 * (16 + x); gb.top = bw + 64 * 32; gb.epoch = 0; }
#define GBAR() grid_bar(gb)
    { pg8::StaticOrder S; S.init(T / 256, NIN / 256, G, c);
      EpiInProj E{qb, (const float*)(ws + WS_ROPE)};
      pg8::gemm_phase(lds, pg8::plain_gemm(h0, WIN, DM), S, E); }
    GBAR();
    { pg8::StaticOrder S; S.init(2, 8, G, c); EpiBf16 E = plain_epi(kx, DM); pg8::gemm_phase(lds, pg8::plain_gemm(memb, WXK, DM), S, E); }
    { pg8::StaticOrder S; S.init(2, 8, G, (c + G / 2) % G); EpiBf16 E = plain_epi(vx, DM); pg8::gemm_phase(lds, pg8::plain_gemm(memb, WXV, DM), S, E); }
    attn_phase(P, lds);
    if (PROBE_MASK & 2) attn_phase(P, lds);
    gating_phase(P, lds);
    if (PROBE_MASK & 4) gating_phase(P, lds);
    GBAR();
    { pg8::StaticOrder S; S.init(2, 32, G, c); pg8::Gemm g = pg8::make_gemm(kx, DM, WXQ, DM, 512); g.a_sh = 3; g.a_mask = 3; g.a_pn = 512; g.b_mask = 7; g.b_sh = 3; g.b_pn2 = 512;
      EpiBf16 E; E.O = Wqk; E.ldc = DM; E.pm_rows = 1024; E.rsh = 3; E.pn_rows = 256; E.cmask = 7; pg8::gemm_phase(lds, g, S, E); }
    { pg8::StaticOrder S; S.init(8, 8, G, (c + G / 2) % G); pg8::Gemm g = pg8::make_gemm(WXO, DM, vx, DM, 512); g.a_sh = 0; g.a_mask = 3; g.a_pn = 512; g.b_mask = 3; g.b_pn = 512; g.b_sh = 2; g.b_pn2 = 256L * DM;
      EpiBf16 E; E.O = VWo; E.ldc = 1024; E.pm_rows = 256; E.rsh = 2; E.pn_rows = 2048; E.cmask = 3; pg8::gemm_phase(lds, g, S, E); }
    merge_phase(P);
    GBAR();
    { pg8::StaticOrder S; S.init(T / 256, DM / 256, G, c); EpiResBf16 E{h0, y12}; pg8::gemm_phase(lds, pg8::plain_gemm(A2, WMIX, DM), S, E); }
    GBAR();
    ln_rows<true, false>(y12, P.ln1_g, P.ln1_b, h1, T);
    GBAR();
    { pg8::StaticOrder S; S.init(T / 256, 4, G, c);
      pg8::Gemm g = pg8::make_gemm(h1, DM, Wqk, DM, DM); g.b_pb = 1024L * DM;
      EpiWrap<EpiSoftmax> E{{Pm, 0.04419417382415922f * 1.4426950408889634f}}; pg8::gemm_phase(lds, g, S, E); }
    GBAR();
    { pg8::StaticOrder S; S.init(T / 256, DM / 256, G, c);
      pg8::Gemm g = pg8::make_gemm(Pm, 1024, VWo, 1024, 1024); g.b_pb = 2048L * 1024;
      EpiResBf16 E{h1, y12}; pg8::gemm_phase(lds, g, S, E); }
    GBAR();
    ln_rows<true, false>(y12, P.ln2_g, P.ln2_b, h2, T);
    GBAR();
    { pg8::StaticOrder S; S.init(T / 256, 2 * DFF / 256, G, c); EpiGateUp E{act}; pg8::gemm_phase(lds, pg8::plain_gemm(h2, WGU, DM), S, E);
      if (PROBE_MASK & 32) { GBAR(); pg8::gemm_phase(lds, pg8::plain_gemm(h2, WGU, DM), S, E); }
      if (PROBE_MASK & 64) { GBAR(); EpiNull EN{(float*)(ws + WS_LSE)}; pg8::gemm_phase(lds, pg8::plain_gemm(h2, WGU, DM), S, EN); } }
    GBAR();
    { pg8::StaticOrder S; S.init(T / 256, DM / 256, G, c); EpiResBf16 E{h2, y3}; pg8::gemm_phase(lds, pg8::plain_gemm(act, WDN, DFF), S, E); }
    GBAR();
    ln_rows<true, true>(y3, P.ln3_g, P.ln3_b, P.out, T);
    if (PROBE_MASK & 256) { for (int i = 0; i < 20; ++i) GBAR(); }
}

extern "C" void kernel_launch(void* const* d_in, const int* in_sizes, int n_in, void* d_out, int out_size, void* d_ws, size_t ws_size, hipStream_t stream) {
    static int grid_blocks = 0;
    if (!grid_blocks) {
        if (n_in != 26 || ws_size < WS_END) { fprintf(stderr, "kernel_launch: unexpected n_in %d / ws_size %zu\n", n_in, ws_size); grid_blocks = -1; return; }
        int dev = 0, cus = 0, per_cu = 0;
        (void)hipGetDevice(&dev);
        (void)hipDeviceGetAttribute(&cus, hipDeviceAttributeMultiprocessorCount, dev);
        if (hipFuncSetAttribute((const void*)mega_fwd, hipFuncAttributeMaxDynamicSharedMemorySize, LDS_BYTES) != hipSuccess) { fprintf(stderr, "hipFuncSetAttribute failed\n"); grid_blocks = -1; return; }
        if (hipOccupancyMaxActiveBlocksPerMultiprocessor(&per_cu, (const void*)mega_fwd, 512, LDS_BYTES) != hipSuccess || per_cu < 1) { fprintf(stderr, "occupancy query: %d\n", per_cu); per_cu = 1; }
        (void)hipGetLastError();
        grid_blocks = cus * 1;
    }
    if (grid_blocks < 0) return;
    Params p{};
    const float** fp = (const float**)&p;
    p.x = (const float*)d_in[0]; p.mem = (const float*)d_in[1]; p.pos = (const int*)d_in[2]; p.ln_in_g = (const float*)d_in[3]; p.ln_in_b = (const float*)d_in[4]; p.w_in = (const float*)d_in[5];
    p.sgu_g = (const float*)d_in[6]; p.sgu_b = (const float*)d_in[7]; p.w_sp = (const float*)d_in[8]; p.b_sp = (const float*)d_in[9]; p.attn_g = (const float*)d_in[10]; p.gmlp_g = (const float*)d_in[11]; p.w_mix = (const float*)d_in[12];
    p.ln1_g = (const float*)d_in[13]; p.ln1_b = (const float*)d_in[14]; p.w_xq = (const float*)d_in[15]; p.w_xk = (const float*)d_in[16]; p.w_xv = (const float*)d_in[17]; p.w_xo = (const float*)d_in[18];
    p.ln2_g = (const float*)d_in[19]; p.ln2_b = (const float*)d_in[20]; p.w_gate = (const float*)d_in[21]; p.w_up = (const float*)d_in[22]; p.w_down = (const float*)d_in[23]; p.ln3_g = (const float*)d_in[24]; p.ln3_b = (const float*)d_in[25];
    p.out = (float*)d_out; p.ws = (unsigned char*)d_ws; (void)fp; (void)out_size; (void)in_sizes;
    (void)hipMemsetAsync((unsigned char*)d_ws + WS_BAR, 0, 16384, stream);
    void* args[] = {&p};
    hipError_t e = hipLaunchCooperativeKernel((const void*)mega_fwd, dim3(grid_blocks), dim3(512), args, LDS_BYTES, stream);
    if (e != hipSuccess) fprintf(stderr, "cooperative launch failed: %s (grid %d)\n", hipGetErrorString(e), grid_blocks);
}
```

```cpp
#include <hip/hip_runtime.h>
#include <hip/hip_cooperative_groups.h>
#include <cstdio>
namespace cg = cooperative_groups;
#ifndef GEMM_SP2
#define GEMM_SP2 1
#endif
#ifndef GEMM_ALIGN
#define GEMM_ALIGN 1
#endif
#ifndef PROBE_MASK
#define PROBE_MASK 0
#endif

#define LAS __attribute__((address_space(3)))
typedef unsigned short bf16_t;
typedef short bf16x8 __attribute__((ext_vector_type(8)));
typedef short s16x4 __attribute__((ext_vector_type(4)));
typedef float f32x4 __attribute__((ext_vector_type(4)));
typedef float f32x2 __attribute__((ext_vector_type(2)));
typedef unsigned u32x4 __attribute__((ext_vector_type(4)));
typedef unsigned u32x2 __attribute__((ext_vector_type(2)));

constexpr int DM = 2048, SEQ = 16384, NB = 2, T = NB * SEQ, NHEAD = 8, AW = 1024, NIN = 5120, MEMLEN = 256, DFF = 5632;
constexpr float ALPHA = 1.189207115002721f, LN_EPS = 1e-5f;
constexpr size_t MiB = 1u << 20;
constexpr size_t WS_WIN = 0, WS_WMIX = 20 * MiB, WS_WXQ = 28 * MiB, WS_WXK = 36 * MiB, WS_WXV = 44 * MiB, WS_WXO = 52 * MiB, WS_WGU = 60 * MiB, WS_WDN = 104 * MiB;
constexpr size_t WS_R0 = 126 * MiB;
constexpr size_t WS_R1 = 254 * MiB;
constexpr size_t WS_R2 = 574 * MiB;
constexpr size_t WS_R3 = 766 * MiB;
constexpr size_t WS_ROPE = 894 * MiB, WS_LSE = 910 * MiB, WS_MEMB = 913 * MiB, WS_KX = 915 * MiB, WS_VT = 917 * MiB, WS_WSP = 919 * MiB, WS_WQK = 920 * MiB, WS_VWO = 928 * MiB, WS_BAR = 936 * MiB, WS_END = 937 * MiB;

struct Params {
    const float* x; const float* mem; const int* pos; const float* ln_in_g; const float* ln_in_b; const float* w_in;
    const float* sgu_g; const float* sgu_b; const float* w_sp; const float* b_sp; const float* attn_g; const float* gmlp_g; const float* w_mix;
    const float* ln1_g; const float* ln1_b; const float* w_xq; const float* w_xk; const float* w_xv; const float* w_xo; const float* ln2_g; const float* ln2_b;
    const float* w_gate; const float* w_up; const float* w_down; const float* ln3_g; const float* ln3_b;
    float* out; unsigned char* ws;
};

__device__ __forceinline__ unsigned cvt_pk_bf16(float lo, float hi) { unsigned r; asm volatile("v_cvt_pk_bf16_f32 %0, %1, %2" : "=v"(r) : "v"(lo), "v"(hi)); return r; }
__device__ __forceinline__ float bf_lo(unsigned w) { return __uint_as_float(w << 16); }
__device__ __forceinline__ float bf_hi(unsigned w) { return __uint_as_float(w & 0xffff0000u); }
__device__ __forceinline__ float wave_sum(float v) {
#pragma unroll
    for (int o = 32; o >= 1; o >>= 1) v += __shfl_xor(v, o);
    return v;
}
__device__ __forceinline__ f32x2 gelu_pk(f32x2 v) {
    const f32x2 av = __builtin_elementwise_abs(v), d = av * 0.2316418882f + 1.0f;
    f32x2 t; t.x = __builtin_amdgcn_rcpf(d.x); t.y = __builtin_amdgcn_rcpf(d.y);
    f32x2 q = t * 0.5307027145f + (-0.7265760135f); q = q * t + 0.7107068705f; q = q * t + (-0.142248368f); q = q * t + 0.127414796f; q = q * t;
    const f32x2 s = (v * v) * (-0.72134752044f);
    f32x2 e; e.x = __builtin_amdgcn_exp2f(s.x); e.y = __builtin_amdgcn_exp2f(s.y);
    const f32x2 m = v * (q * e), r = v - m;
    f32x2 o; o.x = v.x < 0.f ? m.x : r.x; o.y = v.y < 0.f ? m.y : r.y; return o;
}
__device__ __forceinline__ f32x4 gelu4(f32x4 v) { const f32x2 a = gelu_pk((f32x2){v[0], v[1]}), b = gelu_pk((f32x2){v[2], v[3]}); return (f32x4){a.x, a.y, b.x, b.y}; }
__device__ __forceinline__ float silu_f(float g) { return g * __builtin_amdgcn_rcpf(1.0f + __builtin_amdgcn_exp2f(-1.4426950408889634f * g)); }
__device__ __forceinline__ unsigned off_b(unsigned row, unsigned ch) { return 256u * row + 16u * (ch ^ (((row & 3) << 2) | ((row >> 2) & 3))); }

namespace pg8 {
constexpr int BM = 256, BK = 64, HALF = 128, HTB = HALF * BK * 2, STAGE_BYTES = 8 * HTB, NXCD = 8, WGM = 4;
__device__ __forceinline__ int lds_byte(int r, int c) { const int st = (r >> 4) * 2 + (c >> 5), rr = r & 15, cc = c & 31, ob = rr * 64 + cc * 2; return st * 1024 + (ob ^ (((ob >> 9) & 1) << 5)); }
__device__ __forceinline__ void stage_rc(int b, int& R, int& C) { const int st = b / 1024, sb = b % 1024, swz = sb ^ (((sb >> 9) & 1) << 5); R = (st >> 1) * 16 + swz / 64; C = (st & 1) * 32 + (swz % 64) / 2; }
__device__ __forceinline__ int perm32(int rho) { const int n = rho >> 4, i = rho & 15; return 8 * (i >> 2) + 4 * n + (i & 3); }
struct Unit { int pm, pn; };
struct Gemm { const bf16_t* A; const bf16_t* Bt; int lda, ldb, K, a_sh, a_mask, b_mask, b_sh; long a_pm, a_pn, b_pn, b_pn2, b_pb;
    __device__ __forceinline__ const char* aptr(const Unit& u) const { return (const char*)(A + (long)u.pm * a_pm + (long)((u.pn >> a_sh) & a_mask) * a_pn); }
    __device__ __forceinline__ const char* bptr(const Unit& u) const { return (const char*)(Bt + (long)(u.pn & b_mask) * b_pn + (long)(u.pn >> b_sh) * b_pn2 + (long)(u.pm >> 6) * b_pb); } };
__device__ __forceinline__ Gemm make_gemm(const bf16_t* A, int lda, const bf16_t* Bt, int ldb, int K) { Gemm g; g.A = A; g.Bt = Bt; g.lda = lda; g.ldb = ldb; g.K = K; g.a_sh = 0; g.a_mask = 0; g.b_mask = 0x7fffffff; g.b_sh = 31;
    g.a_pm = 256L * lda; g.a_pn = 0; g.b_pn = 256L * ldb; g.b_pn2 = 0; g.b_pb = 0; return g; }
__device__ __forceinline__ Gemm plain_gemm(const bf16_t* A, const bf16_t* Bt, int K) { return make_gemm(A, K, Bt, K, K); }
struct StaticOrder {
    int nM, nN, nwg, G, c;
    __device__ void init(int nM_, int nN_, int G_, int c_) { nM = nM_; nN = nN_; nwg = nM * nN; G = G_; c = c_; }
    __device__ bool next(int i, Unit& u) const {
        const long L = (long)i * G + c; if (L >= nwg) return false;
        int wgid = (int)L; { const int q = nwg / NXCD, r = nwg % NXCD, xcd = wgid % NXCD, off = wgid / NXCD; wgid = (xcd < r ? xcd * (q + 1) : r * (q + 1) + (xcd - r) * q) + off; }
        const int nig = WGM * nN, gid = wgid / nig, fm = gid * WGM, gsz = (nM - fm) < WGM ? (nM - fm) : WGM;
        u.pm = fm + ((wgid % nig) % gsz); u.pn = (wgid % nig) / gsz; return true;
    }
};

template <class Epi>
__device__ __forceinline__ void gemm_phase(LAS unsigned char* lds, const Gemm g, const StaticOrder& S, const Epi& E) {
    int tid = threadIdx.x; asm volatile("" : "+v"(tid));
    const int wid = __builtin_amdgcn_readfirstlane(tid >> 6), lane = tid & 63, wr = wid >> 2, wc = wid & 3, fr = lane & 15, fq = lane >> 4;
    const int K = g.K, nt = K / BK;
    unsigned voffA[2], voffB[2];
#pragma unroll
    for (int i = 0; i < 2; ++i) { int R, C; stage_rc(tid * 16 + i * 8192, R, C); const int Rb = Epi::PERM ? ((R & ~31) + perm32(R & 31)) : R;
        voffA[i] = (unsigned)(R * g.lda + C) * 2u; voffB[i] = (unsigned)(Rb * g.ldb + C) * 2u; }
    const size_t kstep = (size_t)(BK * 2);
    const size_t hA = (size_t)HALF * g.lda * 2, hB = (size_t)HALF * g.ldb * 2;
    const unsigned ldsw = (unsigned)wid * 1024u;
    const int aoff = lds_byte(wr * 64 + fr, fq * 8), boff = lds_byte(wc * 32 + fr, fq * 8);
#define PG8_SA(b, h) (((b) * 2 + (h)) * HTB)
#define PG8_SB(b, h) ((4 + (b) * 2 + (h)) * HTB)
#define PG8_STAGE(bufoff, gbase, voff) do { _Pragma("unroll") for (int _i = 0; _i < 2; ++_i) \
        __builtin_amdgcn_global_load_lds((const unsigned*)((const char*)(gbase) + (voff)[_i]), (LAS unsigned*)(lds + (bufoff) + ldsw + _i * 8192), 16, 0, 0); } while (0)
#define PG8_LDA(dst, b, h) do { _Pragma("unroll") for (int m = 0; m < 4; ++m) _Pragma("unroll") for (int k = 0; k < 2; ++k) dst[m][k] = *(const LAS bf16x8*)(lds + PG8_SA(b, h) + aoff + m * 2048 + k * 1024); } while (0)
#define PG8_LDB(dst, b, h) do { _Pragma("unroll") for (int n = 0; n < 2; ++n) _Pragma("unroll") for (int k = 0; k < 2; ++k) dst[n][k] = *(const LAS bf16x8*)(lds + PG8_SB(b, h) + boff + n * 2048 + k * 1024); } while (0)
#define PG8_MMA(ai, bj, At, Bt) do { __builtin_amdgcn_s_setprio(1); _Pragma("unroll") for (int m = 0; m < 4; ++m) _Pragma("unroll") for (int n = 0; n < 2; ++n) _Pragma("unroll") for (int k = 0; k < 2; ++k) \
        acc[ai][bj][m][n] = __builtin_amdgcn_mfma_f32_16x16x32_bf16(Bt[n][k], At[m][k], acc[ai][bj][m][n], 0, 0, 0); __builtin_amdgcn_s_setprio(0); } while (0)
#define PG8_WAIT_V(n) asm volatile("s_waitcnt vmcnt(" #n ")" ::: "memory")
#define PG8_WAIT_L(n) asm volatile("s_waitcnt lgkmcnt(" #n ")" ::: "memory")
#define PG8_BAR __builtin_amdgcn_s_barrier()
#define PG8_SCHED __builtin_amdgcn_sched_barrier(0)
    Unit cur, nxt; int ui = 0;
    if (!S.next(0, cur)) return;
    f32x4 acc[2][2][4][2];
#pragma unroll
    for (int a = 0; a < 2; ++a)
#pragma unroll
        for (int b = 0; b < 2; ++b)
#pragma unroll
            for (int m = 0; m < 4; ++m)
#pragma unroll
                for (int n = 0; n < 2; ++n) acc[a][b][m][n] = (f32x4){0.f, 0.f, 0.f, 0.f};
    bf16x8 At[4][2], B0[2][2], B1[2][2];
    const char* cA = g.aptr(cur); const char* cB = g.bptr(cur);
#if GEMM_SP2
    PG8_STAGE(PG8_SB(0, 0), cB, voffB); PG8_STAGE(PG8_SB(0, 1), cB + hB, voffB); PG8_STAGE(PG8_SA(0, 0), cA, voffA); PG8_STAGE(PG8_SA(0, 1), cA + hA, voffA);
    if (wr == 1) PG8_BAR;
    PG8_WAIT_V(2); PG8_BAR;
    PG8_STAGE(PG8_SB(1, 0), cB + kstep, voffB); PG8_STAGE(PG8_SA(1, 0), cA + kstep, voffA); PG8_STAGE(PG8_SB(1, 1), cB + hB + kstep, voffB);
    PG8_WAIT_V(6); PG8_BAR;
#else
    PG8_STAGE(PG8_SB(0, 0), cB, voffB); PG8_STAGE(PG8_SA(0, 0), cA, voffA); PG8_STAGE(PG8_SB(0, 1), cB + hB, voffB); PG8_STAGE(PG8_SA(0, 1), cA + hA, voffA);
    if (wr == 1) PG8_BAR;
    PG8_WAIT_V(4); PG8_BAR;
    PG8_STAGE(PG8_SB(1, 0), cB + kstep, voffB); PG8_STAGE(PG8_SA(1, 0), cA + kstep, voffA); PG8_STAGE(PG8_SB(1, 1), cB + hB + kstep, voffB);
    PG8_WAIT_V(6); PG8_BAR;
#endif
    for (;;) {
        const bool has_next = S.next(ui + 1, nxt);
        const char* nA = has_next ? g.aptr(nxt) : cA; const char* nB = has_next ? g.bptr(nxt) : cB;
        for (int t = 0; t < nt; t += 2) {
            const bool last = (t == nt - 2);
            const char* a1 = cA + (size_t)(t + 1) * kstep;
            const char* a2 = last ? nA : cA + (size_t)(t + 2) * kstep; const char* b2 = last ? nB : cB + (size_t)(t + 2) * kstep;
            const char* a3 = a2 + kstep; const char* b3 = b2 + kstep;
#if GEMM_SP2
            PG8_LDB(B0, 0, 0); PG8_LDB(B1, 0, 1); PG8_SCHED; PG8_LDA(At, 0, 0); PG8_STAGE(PG8_SA(1, 1), a1 + hA, voffA);
            PG8_WAIT_V(8); PG8_WAIT_L(0); PG8_BAR; PG8_MMA(0, 0, At, B0); PG8_MMA(0, 1, At, B1); PG8_BAR; PG8_SCHED;
            PG8_LDA(At, 0, 1); PG8_STAGE(PG8_SB(0, 0), b2, voffB); PG8_STAGE(PG8_SB(0, 1), b2 + hB, voffB); PG8_STAGE(PG8_SA(0, 0), a2, voffA);
            PG8_WAIT_V(8); PG8_WAIT_L(0); PG8_BAR; PG8_MMA(1, 0, At, B0); PG8_MMA(1, 1, At, B1); PG8_BAR; PG8_SCHED;
            PG8_LDB(B0, 1, 0); PG8_LDB(B1, 1, 1); PG8_SCHED; PG8_LDA(At, 1, 0); PG8_STAGE(PG8_SA(0, 1), a2 + hA, voffA);
            PG8_WAIT_V(8); PG8_WAIT_L(0); PG8_BAR; PG8_MMA(0, 0, At, B0); PG8_MMA(0, 1, At, B1); PG8_BAR; PG8_SCHED;
            PG8_LDA(At, 1, 1); PG8_STAGE(PG8_SB(1, 0), b3, voffB); PG8_STAGE(PG8_SB(1, 1), b3 + hB, voffB); PG8_STAGE(PG8_SA(1, 0), a3, voffA);
            PG8_WAIT_V(8); PG8_WAIT_L(0); PG8_BAR; PG8_MMA(1, 0, At, B0); PG8_MMA(1, 1, At, B1); PG8_BAR; PG8_SCHED;
#else
            PG8_LDB(B0, 0, 0); PG8_SCHED; PG8_LDA(At, 0, 0); PG8_STAGE(PG8_SA(1, 1), a1 + hA, voffA);
            PG8_WAIT_L(8); PG8_BAR; PG8_WAIT_L(0); PG8_MMA(0, 0, At, B0); PG8_BAR; PG8_SCHED;
            PG8_LDB(B1, 0, 1); PG8_STAGE(PG8_SB(0, 0), b2, voffB);
            PG8_BAR; PG8_WAIT_L(0); PG8_MMA(0, 1, At, B1); PG8_BAR;
            PG8_LDA(At, 0, 1); PG8_STAGE(PG8_SA(0, 0), a2, voffA);
            PG8_BAR; PG8_WAIT_L(0); PG8_MMA(1, 0, At, B0); PG8_BAR; PG8_SCHED;
            PG8_STAGE(PG8_SB(0, 1), b2 + hB, voffB);
            PG8_WAIT_V(6); PG8_BAR; PG8_MMA(1, 1, At, B1); PG8_BAR;
            PG8_LDB(B0, 1, 0); PG8_SCHED; PG8_LDA(At, 1, 0); PG8_STAGE(PG8_SA(0, 1), a2 + hA, voffA);
            PG8_WAIT_L(8); PG8_BAR; PG8_WAIT_L(0); PG8_MMA(0, 0, At, B0); PG8_BAR; PG8_SCHED;
            PG8_LDB(B1, 1, 1); PG8_STAGE(PG8_SB(1, 0), b3, voffB);
            PG8_BAR; PG8_WAIT_L(0); PG8_MMA(0, 1, At, B1); PG8_BAR;
            PG8_LDA(At, 1, 1); PG8_STAGE(PG8_SA(1, 0), a3, voffA);
            PG8_BAR; PG8_WAIT_L(0); PG8_MMA(1, 0, At, B0); PG8_BAR; PG8_SCHED;
            PG8_STAGE(PG8_SB(1, 1), b3 + hB, voffB);
            PG8_WAIT_V(6); PG8_BAR; PG8_MMA(1, 1, At, B1); PG8_BAR;
#endif
        }
#if GEMM_ALIGN
        if (wr == 0) PG8_BAR;
#endif
        E(acc, cur, wr, wc, fr, fq, lds);
        if (!has_next) break;
#pragma unroll
        for (int a = 0; a < 2; ++a)
#pragma unroll
            for (int b = 0; b < 2; ++b)
#pragma unroll
                for (int m = 0; m < 4; ++m)
#pragma unroll
                    for (int n = 0; n < 2; ++n) acc[a][b][m][n] = (f32x4){0.f, 0.f, 0.f, 0.f};
        cur = nxt; cA = nA; cB = nB; ++ui;
#if GEMM_ALIGN
        if (wr == 1) PG8_BAR;
#endif
    }
    PG8_WAIT_V(0);
#if !GEMM_ALIGN
    if (wr == 0) PG8_BAR;
#endif
    PG8_BAR;
#undef PG8_SA
#undef PG8_SB
#undef PG8_STAGE
#undef PG8_LDA
#undef PG8_LDB
#undef PG8_MMA
#undef PG8_WAIT_V
#undef PG8_WAIT_L
#undef PG8_BAR
#undef PG8_SCHED
}
}
using pg8::Unit;

__device__ __forceinline__ u32x4 pack8(f32x4 a, f32x4 b) { u32x4 w; w.x = cvt_pk_bf16(a[0], a[1]); w.y = cvt_pk_bf16(a[2], a[3]); w.z = cvt_pk_bf16(b[0], b[1]); w.w = cvt_pk_bf16(b[2], b[3]); return w; }

struct EpiInProj {
    static constexpr bool PERM = true;
    bf16_t* base; const float* rope;
    __device__ __forceinline__ void operator()(const f32x4 (&acc)[2][2][4][2], const Unit& un, int wr, int wc, int fr, int fq, LAS unsigned char*) const {
        const int row0 = un.pm * 256 + wr * 64 + fr, pn = un.pn;
        if (pn < 8) {
            bf16_t* dst = base + (size_t)(pn >> 2) * ((size_t)T * 1024); const int head = (pn & 3) * 2 + (wc >> 1), e1 = (wc & 1) * 32 + fq * 8;
            f32x4 rr[2][4];
            { const float* rp = rope + ((size_t)row0 * 64 + e1) * 2; rr[0][0] = *(const f32x4*)rp; rr[0][1] = *(const f32x4*)(rp + 4); rr[0][2] = *(const f32x4*)(rp + 8); rr[0][3] = *(const f32x4*)(rp + 12); }
#pragma unroll
            for (int it = 0; it < 8; ++it) {
                const int ai = it >> 2, m = it & 3, row = row0 + ai * 128 + m * 16;
                if (it < 7) { const int ai2 = (it + 1) >> 2, m2 = (it + 1) & 3; const float* rp = rope + ((size_t)(row0 + ai2 * 128 + m2 * 16) * 64 + e1) * 2;
                    rr[(it + 1) & 1][0] = *(const f32x4*)rp; rr[(it + 1) & 1][1] = *(const f32x4*)(rp + 4); rr[(it + 1) & 1][2] = *(const f32x4*)(rp + 8); rr[(it + 1) & 1][3] = *(const f32x4*)(rp + 12); }
                const f32x4 r0 = rr[it & 1][0], r1 = rr[it & 1][1], r2 = rr[it & 1][2], r3 = rr[it & 1][3];
                const f32x4 xa0 = acc[ai][0][m][0], xa1 = acc[ai][0][m][1], xb0 = acc[ai][1][m][0], xb1 = acc[ai][1][m][1];
                const f32x4 c0 = (f32x4){r0[0], r0[2], r1[0], r1[2]}, s0 = (f32x4){r0[1], r0[3], r1[1], r1[3]};
                const f32x4 c1 = (f32x4){r2[0], r2[2], r3[0], r3[2]}, s1 = (f32x4){r2[1], r2[3], r3[1], r3[3]};
                const float qs = (pn < 4) ? 0.08838834764831845f * 1.4426950408889634f : 1.0f;
                const f32x4 oa0 = (xa0 * c0 - xb0 * s0) * qs, oa1 = (xa1 * c1 - xb1 * s1) * qs, ob0 = (xb0 * c0 + xa0 * s0) * qs, ob1 = (xb1 * c1 + xa1 * s1) * qs;
                bf16_t* dp = dst + ((size_t)head * T + row) * 128 + e1;
                *(u32x4*)dp = pack8(oa0, oa1); *(u32x4*)(dp + 64) = pack8(ob0, ob1);
            }
        } else {
            bf16_t* dst = base + (size_t)(pn >> 2) * ((size_t)T * 1024); const bool act = pn >= 12; const int within = wc * 32 + 8 * fq;
#pragma unroll
            for (int ai = 0; ai < 2; ++ai)
#pragma unroll
                for (int m = 0; m < 4; ++m) {
                    const int row = row0 + ai * 128 + m * 16;
#pragma unroll
                    for (int bj = 0; bj < 2; ++bj) { f32x4 v0 = acc[ai][bj][m][0], v1 = acc[ai][bj][m][1];
                        if (act) { v0 = gelu4(v0); v1 = gelu4(v1); }
                        *(u32x4*)(dst + ((size_t)((pn & 3) * 2 + bj) * T + row) * 128 + within) = pack8(v0, v1); }
                }
        }
    }
};
struct EpiBf16 {
    static constexpr bool PERM = true;
    bf16_t* O; int ldc; int pm_rows, rsh, pn_rows, cmask;
    __device__ __forceinline__ void operator()(const f32x4 (&acc)[2][2][4][2], const Unit& un, int wr, int wc, int fr, int fq, LAS unsigned char*) const {
        const int row0 = un.pm * pm_rows + (un.pn >> rsh) * pn_rows + wr * 64 + fr, col0 = (un.pn & cmask) * 256 + wc * 32 + 8 * fq;
#pragma unroll
        for (int ai = 0; ai < 2; ++ai)
#pragma unroll
            for (int m = 0; m < 4; ++m) { bf16_t* dp = O + (size_t)(row0 + ai * 128 + m * 16) * ldc + col0;
#pragma unroll
                for (int bj = 0; bj < 2; ++bj) *(u32x4*)(dp + bj * 128) = pack8(acc[ai][bj][m][0], acc[ai][bj][m][1]); }
    }
};
__device__ __forceinline__ EpiBf16 plain_epi(bf16_t* O, int ldc) { EpiBf16 e; e.O = O; e.ldc = ldc; e.pm_rows = 256; e.rsh = 31; e.pn_rows = 0; e.cmask = 0x7fffffff; return e; }
struct EpiResBf16 {
    static constexpr bool PERM = true;
    const bf16_t* h; bf16_t* Y;
    __device__ __forceinline__ void operator()(const f32x4 (&acc)[2][2][4][2], const Unit& un, int wr, int wc, int fr, int fq, LAS unsigned char*) const {
        const int row0 = un.pm * 256 + wr * 64 + fr, col0 = un.pn * 256 + wc * 32 + 8 * fq;
        u32x4 hv[2][4][2];
#define RES_LOAD(ai_) do { _Pragma("unroll") for (int m = 0; m < 4; ++m) _Pragma("unroll") for (int bj = 0; bj < 2; ++bj) \
            hv[ai_][m][bj] = *(const u32x4*)(h + (size_t)(row0 + (ai_) * 128 + m * 16) * DM + col0 + bj * 128); } while (0)
        RES_LOAD(0); RES_LOAD(1);
#undef RES_LOAD
#pragma unroll
        for (int ai = 0; ai < 2; ++ai)
#pragma unroll
            for (int m = 0; m < 4; ++m)
#pragma unroll
                for (int bj = 0; bj < 2; ++bj) { const u32x4 v = hv[ai][m][bj];
                    const f32x4 h0v = (f32x4){bf_lo(v.x), bf_hi(v.x), bf_lo(v.y), bf_hi(v.y)}, h1v = (f32x4){bf_lo(v.z), bf_hi(v.z), bf_lo(v.w), bf_hi(v.w)};
                    *(u32x4*)(Y + (size_t)(row0 + ai * 128 + m * 16) * DM + col0 + bj * 128) = pack8(h0v * ALPHA + acc[ai][bj][m][0], h1v * ALPHA + acc[ai][bj][m][1]); }
    }
};
struct EpiGateUp {
    static constexpr bool PERM = true;
    bf16_t* act;
    __device__ __forceinline__ void operator()(const f32x4 (&acc)[2][2][4][2], const Unit& un, int wr, int wc, int fr, int fq, LAS unsigned char*) const {
        const int row0 = un.pm * 256 + wr * 64 + fr, col0 = un.pn * 128 + wc * 32 + 8 * fq;
#pragma unroll
        for (int ai = 0; ai < 2; ++ai)
#pragma unroll
            for (int m = 0; m < 4; ++m) { f32x4 o0, o1;
#pragma unroll
                for (int j = 0; j < 4; ++j) { o0[j] = silu_f(acc[ai][0][m][0][j]) * acc[ai][1][m][0][j]; o1[j] = silu_f(acc[ai][0][m][1][j]) * acc[ai][1][m][1][j]; }
                *(u32x4*)(act + (size_t)(row0 + ai * 128 + m * 16) * DFF + col0) = pack8(o0, o1); }
    }
};
struct EpiNull {
    static constexpr bool PERM = true;
    float* sink;
    __device__ __forceinline__ void operator()(const f32x4 (&acc)[2][2][4][2], const Unit& un, int wr, int wc, int fr, int fq, LAS unsigned char*) const {
        float s = 0.f;
#pragma unroll
        for (int ai = 0; ai < 2; ++ai)
#pragma unroll
            for (int bj = 0; bj < 2; ++bj)
#pragma unroll
                for (int m = 0; m < 4; ++m)
#pragma unroll
                    for (int n = 0; n < 2; ++n) s += (acc[ai][bj][m][n][0] + acc[ai][bj][m][n][1]) + (acc[ai][bj][m][n][2] + acc[ai][bj][m][n][3]);
        if (s == 12345.678f) sink[un.pm + fr] = s;
    }
};
struct EpiSoftmax {
    static constexpr bool PERM = true;
    bf16_t* Pm; float scale;
    __device__ __forceinline__ void operator()(f32x4 (&acc)[2][2][4][2], const Unit& un, int wr, int wc, int fr, int fq, LAS unsigned char* lds) const {
        LAS float* tM = (LAS float*)(lds + pg8::STAGE_BYTES); LAS float* tS = tM + 1024;
        float mx[2][4];
#pragma unroll
        for (int ai = 0; ai < 2; ++ai)
#pragma unroll
            for (int m = 0; m < 4; ++m) { float v = -3.0e38f;
#pragma unroll
                for (int bj = 0; bj < 2; ++bj)
#pragma unroll
                    for (int n = 0; n < 2; ++n) { acc[ai][bj][m][n] = acc[ai][bj][m][n] * scale; const f32x4 x = acc[ai][bj][m][n]; v = fmaxf(v, fmaxf(fmaxf(x[0], x[1]), fmaxf(x[2], x[3]))); }
                v = fmaxf(v, __shfl_xor(v, 16)); v = fmaxf(v, __shfl_xor(v, 32));
                if (fq == 0) tM[(ai * 128 + wr * 64 + m * 16 + fr) * 4 + wc] = v; }
        asm volatile("s_waitcnt lgkmcnt(0)" ::: "memory"); __builtin_amdgcn_s_barrier(); asm volatile("" ::: "memory");
#pragma unroll
        for (int ai = 0; ai < 2; ++ai)
#pragma unroll
            for (int m = 0; m < 4; ++m) { const f32x4 t = *(const LAS f32x4*)(tM + (ai * 128 + wr * 64 + m * 16 + fr) * 4);
                const float mm = fmaxf(fmaxf(t[0], t[1]), fmaxf(t[2], t[3])); float s = 0.f;
#pragma unroll
                for (int bj = 0; bj < 2; ++bj)
#pragma unroll
                    for (int n = 0; n < 2; ++n) { f32x4 x = acc[ai][bj][m][n];
#pragma unroll
                        for (int j = 0; j < 4; ++j) { x[j] = __builtin_amdgcn_exp2f(x[j] - mm); s += x[j]; }
                        acc[ai][bj][m][n] = x; }
                s += __shfl_xor(s, 16); s += __shfl_xor(s, 32);
                if (fq == 0) tS[(ai * 128 + wr * 64 + m * 16 + fr) * 4 + wc] = s; mx[ai][m] = mm; }
        asm volatile("s_waitcnt lgkmcnt(0)" ::: "memory"); __builtin_amdgcn_s_barrier(); asm volatile("" ::: "memory");
        const int row0 = un.pm * 256 + wr * 64 + fr, col0 = wc * 32 + 8 * fq;
#pragma unroll
        for (int ai = 0; ai < 2; ++ai)
#pragma unroll
            for (int m = 0; m < 4; ++m) { const f32x4 t = *(const LAS f32x4*)(tS + (ai * 128 + wr * 64 + m * 16 + fr) * 4);
                const float inv = 1.0f / ((t[0] + t[1]) + (t[2] + t[3]));
                bf16_t* dp = Pm + (size_t)(row0 + ai * 128 + m * 16) * 1024 + un.pn * 256 + col0;
#pragma unroll
                for (int bj = 0; bj < 2; ++bj) *(u32x4*)(dp + bj * 128) = pack8(acc[ai][bj][m][0] * inv, acc[ai][bj][m][1] * inv); }
        (void)mx;
    }
};
template <class E> struct EpiWrap { static constexpr bool PERM = E::PERM; E e;
    __device__ __forceinline__ void operator()(f32x4 (&acc)[2][2][4][2], const Unit& un, int wr, int wc, int fr, int fq, LAS unsigned char* lds) const { e(acc, un, wr, wc, fr, fq, lds); } };

template <bool IN_BF16> struct LnRaw { u32x4 r[IN_BF16 ? 4 : 8]; };
template <bool IN_BF16>
__device__ __forceinline__ void ln_load(const void* src, int row, int lane, LnRaw<IN_BF16>& raw) {
    if (IN_BF16) { const bf16_t* sp = (const bf16_t*)src + (size_t)row * DM;
#pragma unroll
        for (int i = 0; i < 4; ++i) raw.r[i] = *(const u32x4*)(sp + (i * 64 + lane) * 8);
    } else { const float* sp = (const float*)src + (size_t)row * DM;
#pragma unroll
        for (int i = 0; i < 8; ++i) raw.r[i] = *(const u32x4*)(sp + (i * 64 + lane) * 4); }
}
template <bool IN_BF16, bool OUT_F32>
__device__ __forceinline__ void ln_rows(const void* src, const float* gam, const float* bet, void* dst, int nrows) {
    int tid = threadIdx.x; asm volatile("" : "+v"(tid));
    const int lane = tid & 63, w = tid >> 6, stride = gridDim.x * 8;
    int row = blockIdx.x * 8 + w;
    LnRaw<IN_BF16> raw;
    if (row < nrows) ln_load<IN_BF16>(src, row, lane, raw);
    for (; row < nrows; row += stride) {
        f32x4 v[8]; float s = 0.f;
        if (IN_BF16) {
#pragma unroll
            for (int i = 0; i < 4; ++i) { const u32x4 a = raw.r[i];
                v[2 * i] = (f32x4){bf_lo(a.x), bf_hi(a.x), bf_lo(a.y), bf_hi(a.y)}; v[2 * i + 1] = (f32x4){bf_lo(a.z), bf_hi(a.z), bf_lo(a.w), bf_hi(a.w)}; }
        } else {
#pragma unroll
            for (int i = 0; i < 8; ++i) v[i] = __builtin_bit_cast(f32x4, raw.r[i]); }
        if (row + stride < nrows) ln_load<IN_BF16>(src, row + stride, lane, raw);
#pragma unroll
        for (int i = 0; i < 8; ++i) s += (v[i][0] + v[i][1]) + (v[i][2] + v[i][3]);
        s = wave_sum(s); const float mu = s * (1.0f / DM); float q = 0.f;
#pragma unroll
        for (int i = 0; i < 8; ++i) { v[i] = v[i] - mu; q += (v[i][0] * v[i][0] + v[i][1] * v[i][1]) + (v[i][2] * v[i][2] + v[i][3] * v[i][3]); }
        q = wave_sum(q); const float rstd = 1.0f / sqrtf(q * (1.0f / DM) + LN_EPS);
#pragma unroll
        for (int i = 0; i < 8; ++i) { const int col = IN_BF16 ? ((i >> 1) * 64 + lane) * 8 + (i & 1) * 4 : (i * 64 + lane) * 4;
            const f32x4 y = v[i] * rstd * *(const f32x4*)(gam + col) + *(const f32x4*)(bet + col);
            if (OUT_F32) *(f32x4*)((float*)dst + (size_t)row * DM + col) = y;
            else { u32x2 o; o.x = cvt_pk_bf16(y[0], y[1]); o.y = cvt_pk_bf16(y[2], y[3]); *(u32x2*)((bf16_t*)dst + (size_t)row * DM + col) = o; } }
    }
}
struct TrJob { const float* src; int ld, k0, col0; bf16_t* dst; int ldd, n0; };
__device__ __forceinline__ void tr_load(const TrJob& j, f32x4 (&v)[2]) {
    const int tid = threadIdx.x;
#pragma unroll
    for (int p = 0; p < 2; ++p) { const int row = (tid >> 4) + 32 * p, c4 = (tid & 15) * 4; v[p] = *(const f32x4*)(j.src + (size_t)(j.k0 + row) * j.ld + j.col0 + c4); }
}
__device__ __forceinline__ void tr_put(const f32x4 (&v)[2], LAS float* tile) {
    const int tid = threadIdx.x;
#pragma unroll
    for (int p = 0; p < 2; ++p) { const int row = (tid >> 4) + 32 * p, c4 = (tid & 15) * 4;
        tile[row * 65 + c4 + 0] = v[p][0]; tile[row * 65 + c4 + 1] = v[p][1]; tile[row * 65 + c4 + 2] = v[p][2]; tile[row * 65 + c4 + 3] = v[p][3]; }
}
__device__ __forceinline__ void tr_get(const TrJob& j, LAS float* tile) {
    const int tid = threadIdx.x, n = tid >> 3, k8 = (tid & 7) * 8; float f[8];
#pragma unroll
    for (int i = 0; i < 8; ++i) f[i] = tile[(k8 + i) * 65 + n];
    u32x4 w; w.x = cvt_pk_bf16(f[0], f[1]); w.y = cvt_pk_bf16(f[2], f[3]); w.z = cvt_pk_bf16(f[4], f[5]); w.w = cvt_pk_bf16(f[6], f[7]);
    *(u32x4*)(j.dst + (size_t)(j.n0 + n) * j.ldd + j.k0 + k8) = w;
}
__device__ __forceinline__ TrJob tr_job(const Params& P, int id) {
    unsigned char* ws = P.ws; TrJob j;
    constexpr int N_IN = 32 * 80, N_SQ = 32 * 32, N_GU = 32 * 176;
    int t = id;
    if (t < N_IN) { const int nt = t % 80, kt = t / 80; int col0 = nt * 64;
        if (nt < 32) { const int t256 = nt >> 2, sub = nt & 3; col0 = t256 * 256 + ((sub & 1) ? 128 : 0) + 64 * (sub >> 1); }
        j.src = P.w_in; j.ld = NIN; j.k0 = kt * 64; j.col0 = col0; j.dst = (bf16_t*)(ws + WS_WIN); j.ldd = DM; j.n0 = nt * 64; return j; }
    t -= N_IN;
    if (t < 4 * N_SQ) { const int wsel = t / N_SQ, r = t % N_SQ, nt = r % 32, kt = r / 32;
        j.src = wsel == 0 ? P.w_mix : wsel == 1 ? P.w_xk : wsel == 2 ? P.w_xv : P.w_xo;
        j.dst = (bf16_t*)(ws + WS_WMIX) + (size_t)(wsel == 0 ? 0 : wsel + 1) * ((size_t)DM * DM);
        j.ld = DM; j.k0 = kt * 64; j.col0 = nt * 64; j.ldd = DM; j.n0 = nt * 64; return j; }
    t -= 4 * N_SQ;
    if (t < N_GU) { const int nt = t % 176, kt = t / 176, t256 = nt >> 2, sub = nt & 3;
        j.src = (sub < 2) ? P.w_gate : P.w_up; j.ld = DFF; j.k0 = kt * 64; j.col0 = t256 * 128 + (sub & 1) * 64; j.dst = (bf16_t*)(ws + WS_WGU); j.ldd = DM; j.n0 = nt * 64; return j; }
    t -= N_GU;
    { const int nt = t % 32, kt = t / 32; j.src = P.w_down; j.ld = DM; j.k0 = kt * 64; j.col0 = nt * 64; j.dst = (bf16_t*)(ws + WS_WDN); j.ldd = DFF; j.n0 = nt * 64; }
    return j;
}

__device__ __forceinline__ void prep_phase(const Params& P, LAS unsigned char* lds) {
    unsigned char* ws = P.ws; const int tid = threadIdx.x, G = gridDim.x;
    LAS float* tile = (LAS float*)lds;
    constexpr int N_ALL = 32 * 80 + 4 * 32 * 32 + 32 * 176 + 88 * 32;
    { int id = blockIdx.x; f32x4 v[2]; TrJob cur;
      if (id < N_ALL) { cur = tr_job(P, id); tr_load(cur, v); }
      int par = 0;
      while (id < N_ALL) {
          LAS float* tl = tile + par * (64 * 65);
          tr_put(v, tl);
          const int nid = id + G; TrJob nxt = cur;
          if (nid < N_ALL) { nxt = tr_job(P, nid); tr_load(nxt, v); }
          __syncthreads();
          tr_get(cur, tl);
          cur = nxt; id = nid; par ^= 1;
      }
      __syncthreads(); }
    ln_rows<false, false>(P.x, P.ln_in_g, P.ln_in_b, ws + WS_R0, T);
    const size_t gtid = (size_t)blockIdx.x * 512 + tid, gsz = (size_t)G * 512;
    for (size_t i = gtid; i < (size_t)DM * DM / 4; i += gsz) { const f32x4 v = *(const f32x4*)(P.w_xq + i * 4); u32x2 o; o.x = cvt_pk_bf16(v[0], v[1]); o.y = cvt_pk_bf16(v[2], v[3]); *(u32x2*)((bf16_t*)(ws + WS_WXQ) + i * 4) = o; }
    for (size_t i = gtid; i < (size_t)NB * MEMLEN * DM / 4; i += gsz) { const f32x4 v = *(const f32x4*)(P.mem + i * 4); u32x2 o; o.x = cvt_pk_bf16(v[0], v[1]); o.y = cvt_pk_bf16(v[2], v[3]); *(u32x2*)((bf16_t*)(ws + WS_MEMB) + i * 4) = o; }
    for (size_t i = gtid; i < (size_t)8 * 128 * 128; i += gsz) { const int j = (int)(i & 127), ii = (int)((i >> 7) & 127); const float v = (j <= ii) ? P.w_sp[i] : 0.f; ((bf16_t*)(ws + WS_WSP))[i] = (bf16_t)(cvt_pk_bf16(v, 0.f) & 0xffffu); }
    const double th_own = exp(-(double)(int)(gtid & 63) * (9.210340371976184 / 64.0));
    for (size_t i = gtid; i < (size_t)T * 64; i += gsz) { const int tok = (int)(i >> 6);
        const double th = ((gsz & 63) == 0) ? th_own : exp(-(double)(int)(i & 63) * (9.210340371976184 / 64.0)); const double a = (double)P.pos[tok] * th;
        const double qd = rint(a * 0.6366197723675814); double r = fma(-qd, 1.5707963267948966, a); r = fma(-qd, 6.123233995736766e-17, r);
        const int qi = ((int)(long long)qd) & 3; const double r2 = r * r;
        const double sn = r * (1.0 + r2 * (-1.0 / 6 + r2 * (1.0 / 120 + r2 * (-1.0 / 5040 + r2 * (1.0 / 362880 + r2 * (-1.0 / 39916800))))));
        const double cs = 1.0 + r2 * (-0.5 + r2 * (1.0 / 24 + r2 * (-1.0 / 720 + r2 * (1.0 / 40320 + r2 * (-1.0 / 3628800 + r2 * (1.0 / 479001600))))));
        double c, s; if (qi == 0) { c = cs; s = sn; } else if (qi == 1) { c = -sn; s = cs; } else if (qi == 2) { c = -cs; s = -sn; } else { c = sn; s = -cs; }
        *(f32x2*)((float*)(ws + WS_ROPE) + i * 2) = (f32x2){(float)c, (float)s}; }
}

struct AttnProb { int br, d, blk, h, base_tok; };
__device__ __forceinline__ AttnProb attn_decode(int p) {
    AttnProb a; a.br = p >> 11; const int rem = p & 2047, dl = a.br * 2, nb = 128 >> dl; a.d = 1 << dl;
    a.blk = rem & (nb - 1); int t = rem >> (7 - dl); const int r = t & (a.d - 1); t >>= dl; a.h = t & 7; a.base_tok = (t >> 3) * SEQ + r; return a;
}
__device__ __forceinline__ void attn_phase(const Params& P, LAS unsigned char* lds) {
    unsigned char* ws = P.ws;
    const bf16_t* qb = (const bf16_t*)(ws + WS_R1); const bf16_t* kb = qb + (size_t)T * 1024; const bf16_t* vb = kb + (size_t)T * 1024;
    bf16_t* obr = (bf16_t*)(ws + WS_R2); float* lse = (float*)(ws + WS_LSE);
    int tid = threadIdx.x; asm volatile("" : "+v"(tid));
    const int lane = tid & 63, w = __builtin_amdgcn_readfirstlane(tid >> 6), n = lane & 15, g = lane >> 4;
    LAS unsigned char* Kimg = lds; LAS unsigned char* Vimg = lds + 65536;
    const int G = gridDim.x; int p0, pend;
    if (G == 256) { const int cb = blockIdx.x; const bool gw = (cb < 16) || (cb >= 128 && cb < 144);
        const int ng = cb < 16 ? cb : (cb < 128 ? 16 : (cb < 144 ? 16 + (cb - 128) : 32));
        p0 = ng * 17 + (cb - ng) * 25; pend = p0 + (gw ? 17 : 25); }
    else { const int ppw = (6144 + G - 1) / G; p0 = blockIdx.x * ppw; pend = p0 + ppw; }
    if (pend > 6144) pend = 6144;
    if (p0 >= pend) return;
    const int kt0 = 2 * (w >> 1), iq = 16 * w + n;
    const unsigned trq = (unsigned)(n >> 2), trp = (unsigned)(n & 3);
    const int srow = tid >> 4, sch = tid & 15;
    u32x4 pk[4], pv[4]; bf16x8 qf[4];
    AttnProb cur = attn_decode(p0);
#define ATT_LOAD_TILE(pr, blkidx) do { _Pragma("unroll") for (int i = 0; i < 4; ++i) { const int j = (blkidx) * 128 + srow + 32 * i; \
        const size_t o = ((size_t)(pr).h * T + (pr).base_tok + j * (pr).d) * 128 + sch * 8; pk[i] = *(const u32x4*)(kb + o); pv[i] = *(const u32x4*)(vb + o); } } while (0)
#define ATT_PUT_TILE(slot) do { _Pragma("unroll") for (int i = 0; i < 4; ++i) { const unsigned row = (unsigned)(srow + 32 * i); \
        const unsigned prow = (row & ~31u) | (((row >> 2) & 3u) << 3) | (((row >> 4) & 1u) << 2) | (row & 3u); \
        *(LAS u32x4*)(Kimg + off_b((unsigned)(slot) * 128u + row, (unsigned)sch)) = pk[i]; *(LAS u32x4*)(Vimg + off_b((unsigned)(slot) * 128u + prow, (unsigned)sch)) = pv[i]; } } while (0)
#define ATT_LOAD_Q(pr) do { const int tq_ = (pr).base_tok + ((pr).blk * 128 + iq) * (pr).d; _Pragma("unroll") for (int s_ = 0; s_ < 4; ++s_) qf[s_] = *(const bf16x8*)(qb + ((size_t)(pr).h * T + tq_) * 128 + 32 * s_ + 8 * g); } while (0)
    if (cur.blk > 0) { ATT_LOAD_TILE(cur, cur.blk - 1); } else {
#pragma unroll
        for (int i = 0; i < 4; ++i) { pk[i] = (u32x4){0u, 0u, 0u, 0u}; pv[i] = (u32x4){0u, 0u, 0u, 0u}; } }
    ATT_PUT_TILE((cur.blk & 1) ^ 1);
    ATT_LOAD_TILE(cur, cur.blk);
    ATT_PUT_TILE(cur.blk & 1);
    ATT_LOAD_Q(cur);
    __syncthreads();
    for (int p = p0; p < pend; ++p) {
        const int sc = cur.blk & 1, blk = cur.blk;
        const int tq = cur.base_tok + (blk * 128 + iq) * cur.d;
        f32x4 sacc[10]; bf16x8 kfr[2][4]; float mx = -3.0e38f;
#define ATT_LDK(i_, buf_) do { const int kt_ = kt0 + (i_); const unsigned prow_ = (unsigned)(((sc ^ ((kt_ >> 3) ^ 1)) << 7) | ((16 * kt_ + n) & 127)); \
        _Pragma("unroll") for (int s_ = 0; s_ < 4; ++s_) kfr[buf_][s_] = *(const LAS bf16x8*)(Kimg + off_b(prow_, (unsigned)(4 * s_ + g))); } while (0)
#define ATT_MASK(i_) do { if ((i_) < 2 || (i_) > 7) { _Pragma("unroll") for (int e = 0; e < 4; ++e) { const int kpos = 16 * (kt0 + (i_)) + 4 * g + e; \
                const bool valid = (kpos >= iq) && (kpos <= iq + 128) && (blk > 0 || kpos >= 128); const float sc2 = valid ? sacc[i_][e] : -3.0e38f; sacc[i_][e] = sc2; mx = fmaxf(mx, sc2); } } \
            else { const bool tile_ok = (blk > 0) || (kt0 + (i_) >= 8); _Pragma("unroll") for (int e = 0; e < 4; ++e) { const float sc2 = tile_ok ? sacc[i_][e] : -3.0e38f; sacc[i_][e] = sc2; mx = fmaxf(mx, sc2); } } } while (0)
        ATT_LDK(0, 0);
#pragma unroll
        for (int i = 0; i < 10; ++i) { sacc[i] = (f32x4){0.f, 0.f, 0.f, 0.f};
            if (i < 9) ATT_LDK(i + 1, (i + 1) & 1);
            __builtin_amdgcn_sched_barrier(0);
#pragma unroll
            for (int s = 0; s < 4; ++s) sacc[i] = __builtin_amdgcn_mfma_f32_16x16x32_bf16(kfr[i & 1][s], qf[s], sacc[i], 0, 0, 0);
            if (i > 0) ATT_MASK(i - 1);
            __builtin_amdgcn_sched_barrier(0); }
        ATT_MASK(9);
#undef ATT_LDK
#undef ATT_MASK
        const bool has_next = (p + 1 < pend);
        AttnProb nxt = cur;
        if (has_next) { nxt = attn_decode(p + 1); ATT_LOAD_TILE(nxt, nxt.blk); ATT_LOAD_Q(nxt); }
        mx = fmaxf(mx, __shfl_xor(mx, 16)); mx = fmaxf(mx, __shfl_xor(mx, 32));
        float l = 0.f; bf16x8 pb; s16x4 tl[8][2]; f32x4 oacc[8];
#define ATT_EXP(k_) do { u32x4 wv_; float pe_[8]; _Pragma("unroll") for (int e = 0; e < 4; ++e) { pe_[e] = __builtin_amdgcn_exp2f(sacc[2 * (k_)][e] - mx); pe_[4 + e] = __builtin_amdgcn_exp2f(sacc[2 * (k_) + 1][e] - mx); } \
            l += ((pe_[0] + pe_[1]) + (pe_[2] + pe_[3])) + ((pe_[4] + pe_[5]) + (pe_[6] + pe_[7])); \
            wv_.x = cvt_pk_bf16(pe_[0], pe_[1]); wv_.y = cvt_pk_bf16(pe_[2], pe_[3]); wv_.z = cvt_pk_bf16(pe_[4], pe_[5]); wv_.w = cvt_pk_bf16(pe_[6], pe_[7]); pb = __builtin_bit_cast(bf16x8, wv_); } while (0)
#define ATT_LDV(k_) do { const int ks_ = (kt0 >> 1) + (k_); const unsigned rb_ = (unsigned)(((sc ^ ((ks_ >> 2) ^ 1)) << 7) | (32 * (ks_ & 3))) + 8u * g + trq; \
            _Pragma("unroll") for (int c_ = 0; c_ < 8; ++c_) { \
            tl[c_][0] = __builtin_amdgcn_ds_read_tr16_b64_v4i16((LAS s16x4*)(Vimg + off_b(rb_, 2u * c_ + (trp >> 1)) + 8u * (trp & 1))); \
            tl[c_][1] = __builtin_amdgcn_ds_read_tr16_b64_v4i16((LAS s16x4*)(Vimg + off_b(rb_ + 4u, 2u * c_ + (trp >> 1)) + 8u * (trp & 1))); } } while (0)
#pragma unroll
        for (int c = 0; c < 8; ++c) oacc[c] = (f32x4){0.f, 0.f, 0.f, 0.f};
#pragma unroll
        for (int k = 0; k < 5; ++k) {
            ATT_LDV(k);
            ATT_EXP(k);
#pragma unroll
            for (int c = 0; c < 8; ++c) { const s16x4 lo = tl[c][0], hi = tl[c][1];
                const bf16x8 vf = (bf16x8){lo[0], lo[1], lo[2], lo[3], hi[0], hi[1], hi[2], hi[3]};
                oacc[c] = __builtin_amdgcn_mfma_f32_16x16x32_bf16(vf, pb, oacc[c], 0, 0, 0); }
            __builtin_amdgcn_sched_barrier(0); }
#undef ATT_EXP
#undef ATT_LDV
        l += __shfl_xor(l, 16); l += __shfl_xor(l, 32);
        const float inv = 1.0f / l;
        bf16_t* op = obr + ((size_t)cur.br * T + tq) * 1024 + cur.h * 128 + 4 * g;
#pragma unroll
        for (int c = 0; c < 8; ++c) { u32x2 o; o.x = cvt_pk_bf16(oacc[c][0] * inv, oacc[c][1] * inv); o.y = cvt_pk_bf16(oacc[c][2] * inv, oacc[c][3] * inv); *(u32x2*)(op + 16 * c) = o; }
        if (g == 0) lse[((size_t)cur.br * T + tq) * 8 + cur.h] = (mx + __builtin_amdgcn_logf(l)) * 0.6931471805599453f;
        __syncthreads();
        if (has_next) {
            ATT_PUT_TILE(nxt.blk & 1);
            if (nxt.blk == 0) {
#pragma unroll
                for (int i = 0; i < 4; ++i) { pk[i] = (u32x4){0u, 0u, 0u, 0u}; pv[i] = (u32x4){0u, 0u, 0u, 0u}; }
                ATT_PUT_TILE(1); }
        }
        __syncthreads();
        cur = nxt;
    }
#undef ATT_LOAD_TILE
#undef ATT_PUT_TILE
#undef ATT_LOAD_Q
}

__device__ __forceinline__ void unpack16(const u32x4 a, const u32x4 b, float (&f)[16]) {
    f[0] = bf_lo(a.x); f[1] = bf_hi(a.x); f[2] = bf_lo(a.y); f[3] = bf_hi(a.y); f[4] = bf_lo(a.z); f[5] = bf_hi(a.z); f[6] = bf_lo(a.w); f[7] = bf_hi(a.w);
    f[8] = bf_lo(b.x); f[9] = bf_hi(b.x); f[10] = bf_lo(b.y); f[11] = bf_hi(b.y); f[12] = bf_lo(b.z); f[13] = bf_hi(b.z); f[14] = bf_lo(b.w); f[15] = bf_hi(b.w);
}
__device__ __forceinline__ void gating_phase(const Params& P, LAS unsigned char* lds) {
    unsigned char* ws = P.ws;
    const bf16_t* ub = (const bf16_t*)(ws + WS_R1) + (size_t)3 * T * 1024; const bf16_t* gb = ub + (size_t)T * 1024;
    bf16_t* A2 = (bf16_t*)(ws + WS_R3); const bf16_t* wsp = (const bf16_t*)(ws + WS_WSP);
    int tid = threadIdx.x; asm volatile("" : "+v"(tid));
    const int lane = tid & 63, w = __builtin_amdgcn_readfirstlane(tid >> 6), n = lane & 15, g = lane >> 4;
    LAS float* stat = (LAS float*)(lds + 65536);
    const unsigned trq = (unsigned)(n >> 2), trp = (unsigned)(n & 3);
    const int srow = tid >> 4, sch = tid & 15;
    for (int chunk = blockIdx.x; chunk < T / 128; chunk += gridDim.x) {
        const int tok0 = chunk * 128;
#pragma unroll
        for (int bt = 0; bt < 2; ++bt) { u32x4 ra[8], rb[8];
#pragma unroll
            for (int rr = 0; rr < 8; ++rr) { const bf16_t* gp = gb + ((size_t)(lane >> 3) * T + tok0 + 16 * w + bt * 8 + rr) * 128 + (lane & 7) * 16; ra[rr] = *(const u32x4*)gp; rb[rr] = *(const u32x4*)(gp + 8); }
#pragma unroll
            for (int rr = 0; rr < 8; ++rr) { float f[16]; unpack16(ra[rr], rb[rr], f); float s = 0.f;
#pragma unroll
                for (int j = 0; j < 16; ++j) s += f[j];
                s = wave_sum(s); const float mu = s * (1.0f / 1024.0f); float q = 0.f;
#pragma unroll
                for (int j = 0; j < 16; ++j) { const float dd = f[j] - mu; q += dd * dd; }
                q = wave_sum(q);
                if (lane == 0) { const int row = 16 * w + bt * 8 + rr; stat[row * 2] = mu; stat[row * 2 + 1] = 1.0f / sqrtf(q * (1.0f / 1024.0f) + LN_EPS); } } }
        u32x4 traw[4];
#pragma unroll
        for (int i = 0; i < 4; ++i) traw[i] = *(const u32x4*)(gb + (size_t)(tok0 + srow + 32 * i) * 128 + sch * 8);
        __syncthreads();
        const int pos = 16 * w + n, tok = tok0 + pos, nks = (w >> 1) + 1;
        for (int gi = 0; gi < 8; ++gi) {
            LAS unsigned char* img = lds + (gi & 1) * 32768;
            { const int c0 = gi * 128 + sch * 8;
              const f32x4 g0 = *(const f32x4*)(P.sgu_g + c0), g1 = *(const f32x4*)(P.sgu_g + c0 + 4), b0 = *(const f32x4*)(P.sgu_b + c0), b1 = *(const f32x4*)(P.sgu_b + c0 + 4);
#pragma unroll
              for (int i = 0; i < 4; ++i) { const int row = srow + 32 * i; const u32x4 a = traw[i]; const float mu = stat[row * 2], rs = stat[row * 2 + 1];
                const f32x4 x0 = (f32x4){bf_lo(a.x), bf_hi(a.x), bf_lo(a.y), bf_hi(a.y)}, x1 = (f32x4){bf_lo(a.z), bf_hi(a.z), bf_lo(a.w), bf_hi(a.w)};
                *(LAS u32x4*)(img + off_b((unsigned)row, (unsigned)sch)) = pack8((x0 - mu) * rs * g0 + b0, (x1 - mu) * rs * g1 + b1); } }
            if (gi < 7) {
#pragma unroll
                for (int i = 0; i < 4; ++i) traw[i] = *(const u32x4*)(gb + ((size_t)(gi + 1) * T + tok0 + srow + 32 * i) * 128 + sch * 8); }
            bf16x8 wf[4]; u32x2 uv[8];
#pragma unroll
            for (int ks = 0; ks < 4; ++ks) wf[ks] = (ks < nks) ? *(const bf16x8*)(wsp + (size_t)(gi * 128 + pos) * 128 + 32 * ks + 8 * g) : (bf16x8){0, 0, 0, 0, 0, 0, 0, 0};
#pragma unroll
            for (int c = 0; c < 8; ++c) uv[c] = *(const u32x2*)(ub + ((size_t)gi * T + tok) * 128 + 16 * c + 4 * g);
            const float bs = P.b_sp[gi * 128 + pos];
            __syncthreads();
            s16x4 tg[2][4][2];
#define GAT_LD(c_, buf_) do { _Pragma("unroll") for (int ks_ = 0; ks_ < 4; ++ks_) if (ks_ < nks) { \
                tg[buf_][ks_][0] = __builtin_amdgcn_ds_read_tr16_b64_v4i16((LAS s16x4*)(img + off_b(32u * ks_ + 8u * g + trq, 2u * (c_) + (trp >> 1)) + 8u * (trp & 1))); \
                tg[buf_][ks_][1] = __builtin_amdgcn_ds_read_tr16_b64_v4i16((LAS s16x4*)(img + off_b(32u * ks_ + 8u * g + 4u + trq, 2u * (c_) + (trp >> 1)) + 8u * (trp & 1))); } } while (0)
            GAT_LD(0, 0);
#pragma unroll
            for (int c = 0; c < 8; ++c) { f32x4 acc = (f32x4){0.f, 0.f, 0.f, 0.f};
                if (c < 7) GAT_LD(c + 1, (c + 1) & 1);
                __builtin_amdgcn_sched_barrier(0);
#pragma unroll
                for (int ks = 0; ks < 4; ++ks) if (ks < nks) { const s16x4 lo = tg[c & 1][ks][0], hi = tg[c & 1][ks][1];
                    const bf16x8 vf = (bf16x8){lo[0], lo[1], lo[2], lo[3], hi[0], hi[1], hi[2], hi[3]};
                    acc = __builtin_amdgcn_mfma_f32_16x16x32_bf16(vf, wf[ks], acc, 0, 0, 0); }
                u32x2 o; o.x = cvt_pk_bf16(bf_lo(uv[c].x) * (acc[0] + bs), bf_hi(uv[c].x) * (acc[1] + bs)); o.y = cvt_pk_bf16(bf_lo(uv[c].y) * (acc[2] + bs), bf_hi(uv[c].y) * (acc[3] + bs));
                *(u32x2*)(A2 + (size_t)tok * 2048 + 1024 + gi * 128 + 16 * c + 4 * g) = o;
                __builtin_amdgcn_sched_barrier(0); }
#undef GAT_LD
        }
        __syncthreads();
    }
}

struct MergeRaw { u32x4 a[3], b[3], ga, gbq; float l[3]; };
__device__ __forceinline__ void merge_load(const bf16_t* obr, const float* lse, const bf16_t* A2, int tok, int h, int c0, MergeRaw& m) {
#pragma unroll
    for (int r = 0; r < 3; ++r) { const bf16_t* sp = obr + ((size_t)r * T + tok) * 1024 + c0; m.a[r] = *(const u32x4*)sp; m.b[r] = *(const u32x4*)(sp + 8); m.l[r] = lse[((size_t)r * T + tok) * 8 + h]; }
    const bf16_t* gp = A2 + (size_t)tok * 2048 + 1024 + c0; m.ga = *(const u32x4*)gp; m.gbq = *(const u32x4*)(gp + 8);
}
__device__ __forceinline__ void merge_phase(const Params& P) {
    unsigned char* ws = P.ws; const bf16_t* obr = (const bf16_t*)(ws + WS_R2); const float* lse = (const float*)(ws + WS_LSE); bf16_t* A2 = (bf16_t*)(ws + WS_R3);
    int tid = threadIdx.x; asm volatile("" : "+v"(tid));
    const int lane = tid & 63, w = tid >> 6, h = lane >> 3, c0 = lane * 16, stride = gridDim.x * 8;
    f32x4 ga[4], gg[4];
#pragma unroll
    for (int i = 0; i < 4; ++i) { ga[i] = *(const f32x4*)(P.attn_g + c0 + 4 * i); gg[i] = *(const f32x4*)(P.gmlp_g + c0 + 4 * i); }
    int tok = blockIdx.x * 8 + w; MergeRaw m;
    if (tok < T) merge_load(obr, lse, A2, tok, h, c0, m);
    for (; tok < T; tok += stride) {
        float l0 = m.l[0], l1 = m.l[1], l2 = m.l[2];
        const float mm = fmaxf(l0, fmaxf(l1, l2)); l0 = __expf(l0 - mm); l1 = __expf(l1 - mm); l2 = __expf(l2 - mm);
        const float inv = 1.0f / (l0 + l1 + l2); const float wt[3] = {l0 * inv, l1 * inv, l2 * inv};
        float o[16], x[16];
#pragma unroll
        for (int j = 0; j < 16; ++j) o[j] = 0.f;
#pragma unroll
        for (int r = 0; r < 3; ++r) { float f[16]; unpack16(m.a[r], m.b[r], f);
#pragma unroll
            for (int j = 0; j < 16; ++j) o[j] += wt[r] * f[j]; }
        unpack16(m.ga, m.gbq, x);
        if (tok + stride < T) merge_load(obr, lse, A2, tok + stride, h, c0, m);
        float ss = 0.f, sg = 0.f;
#pragma unroll
        for (int j = 0; j < 16; ++j) { ss += o[j] * o[j]; sg += x[j] * x[j]; }
        ss = wave_sum(ss); sg = wave_sum(sg);
        const float rs = 1.0f / sqrtf(ss * (1.0f / 1024.0f) + LN_EPS), rg = 1.0f / sqrtf(sg * (1.0f / 1024.0f) + LN_EPS);
        bf16_t* dp = A2 + (size_t)tok * 2048 + c0;
        { u32x4 w0, w1; w0.x = cvt_pk_bf16(o[0] * rs * ga[0][0], o[1] * rs * ga[0][1]); w0.y = cvt_pk_bf16(o[2] * rs * ga[0][2], o[3] * rs * ga[0][3]); w0.z = cvt_pk_bf16(o[4] * rs * ga[1][0], o[5] * rs * ga[1][1]); w0.w = cvt_pk_bf16(o[6] * rs * ga[1][2], o[7] * rs * ga[1][3]);
          w1.x = cvt_pk_bf16(o[8] * rs * ga[2][0], o[9] * rs * ga[2][1]); w1.y = cvt_pk_bf16(o[10] * rs * ga[2][2], o[11] * rs * ga[2][3]); w1.z = cvt_pk_bf16(o[12] * rs * ga[3][0], o[13] * rs * ga[3][1]); w1.w = cvt_pk_bf16(o[14] * rs * ga[3][2], o[15] * rs * ga[3][3]);
          *(u32x4*)dp = w0; *(u32x4*)(dp + 8) = w1; }
        { u32x4 w0, w1; w0.x = cvt_pk_bf16(x[0] * rg * gg[0][0], x[1] * rg * gg[0][1]); w0.y = cvt_pk_bf16(x[2] * rg * gg[0][2], x[3] * rg * gg[0][3]); w0.z = cvt_pk_bf16(x[4] * rg * gg[1][0], x[5] * rg * gg[1][1]); w0.w = cvt_pk_bf16(x[6] * rg * gg[1][2], x[7] * rg * gg[1][3]);
          w1.x = cvt_pk_bf16(x[8] * rg * gg[2][0], x[9] * rg * gg[2][1]); w1.y = cvt_pk_bf16(x[10] * rg * gg[2][2], x[11] * rg * gg[2][3]); w1.z = cvt_pk_bf16(x[12] * rg * gg[3][0], x[13] * rg * gg[3][1]); w1.w = cvt_pk_bf16(x[14] * rg * gg[3][2], x[15] * rg * gg[3][3]);
          *(u32x4*)(dp + 1024) = w0; *(u32x4*)(dp + 1032) = w1; }
    }
}

struct GridBar { unsigned* xarr; unsigned* top; unsigned nx, nxcd, epoch; };
__device__ __forceinline__ unsigned xcc_id() { return (unsigned)__builtin_amdgcn_s_getreg((3 << 11) | 20) & 0xFu; }
__device__ __forceinline__ void grid_bar(GridBar& b) {
    asm volatile("s_waitcnt vmcnt(0) lgkmcnt(0)" ::: "memory");
    __syncthreads();
    b.epoch += 1;
    if (threadIdx.x == 0) {
        const unsigned old = __hip_atomic_fetch_add(b.xarr, 1u, __ATOMIC_RELAXED, __HIP_MEMORY_SCOPE_AGENT);
        if (old + 1 == b.epoch * b.nx) {
            __builtin_amdgcn_fence(__ATOMIC_RELEASE, "agent");
            asm volatile("s_waitcnt vmcnt(0)" ::: "memory");
            __hip_atomic_fetch_add(b.top, 1u, __ATOMIC_RELAXED, __HIP_MEMORY_SCOPE_AGENT);
        }
        const unsigned want = b.epoch * b.nxcd;
        while (__hip_atomic_load(b.top, __ATOMIC_RELAXED, __HIP_MEMORY_SCOPE_AGENT) < want) __builtin_amdgcn_s_sleep(2);
        __builtin_amdgcn_fence(__ATOMIC_ACQUIRE, "agent");
        asm volatile("s_waitcnt vmcnt(0)" ::: "memory");
    }
    asm volatile("" ::: "memory"); __syncthreads(); asm volatile("" ::: "memory");
}

constexpr int LDS_BYTES = pg8::STAGE_BYTES + 8192;

__global__ void __launch_bounds__(512) mega_fwd(Params P) {
    extern __shared__ __attribute__((aligned(16))) unsigned char lds_raw[];
    LAS unsigned char* lds = (LAS unsigned char*)lds_raw;
    cg::grid_group grid = cg::this_grid();
    unsigned char* ws = P.ws; const int G = gridDim.x, c = blockIdx.x;
    bf16_t* const WIN = (bf16_t*)(ws + WS_WIN); bf16_t* const WMIX = (bf16_t*)(ws + WS_WMIX); bf16_t* const WXQ = (bf16_t*)(ws + WS_WXQ); bf16_t* const WXK = (bf16_t*)(ws + WS_WXK);
    bf16_t* const WXV = (bf16_t*)(ws + WS_WXV); bf16_t* const WXO = (bf16_t*)(ws + WS_WXO); bf16_t* const WGU = (bf16_t*)(ws + WS_WGU); bf16_t* const WDN = (bf16_t*)(ws + WS_WDN);
    bf16_t* const h0 = (bf16_t*)(ws + WS_R0); bf16_t* const act = (bf16_t*)(ws + WS_R0);
    bf16_t* const qb = (bf16_t*)(ws + WS_R1); bf16_t* const y12 = (bf16_t*)(ws + WS_R1); bf16_t* const y3 = (bf16_t*)(ws + WS_R2); bf16_t* const Pm = (bf16_t*)(ws + WS_R1 + 256 * MiB);
    bf16_t* const h1 = (bf16_t*)(ws + WS_R2); bf16_t* const A2 = (bf16_t*)(ws + WS_R3); bf16_t* const h2 = (bf16_t*)(ws + WS_R3);
    bf16_t* const memb = (bf16_t*)(ws + WS_MEMB); bf16_t* const kx = (bf16_t*)(ws + WS_KX); bf16_t* const vx = (bf16_t*)(ws + WS_VT); bf16_t* const Wqk = (bf16_t*)(ws + WS_WQK); bf16_t* const VWo = (bf16_t*)(ws + WS_VWO);

    if (threadIdx.x == 0) __hip_atomic_fetch_add((unsigned*)(ws + WS_BAR) + 64 * xcc_id(), 1u, __ATOMIC_RELAXED, __HIP_MEMORY_SCOPE_AGENT);
    prep_phase(P, lds);
    if (PROBE_MASK & 1) { grid.sync(); prep_phase(P, lds); }
    grid.sync();
    GridBar gb;
    { unsigned* const bw = (unsigned*)(ws + WS_BAR); const unsigned x = xcc_id(); unsigned n = 0;
      for (int j = 0; j < 16; ++j) n += (__hip_atomic_load(bw + 64 * j, __ATOMIC_RELAXED, __HIP_MEMORY_SCOPE_AGENT) != 0u) ? 1u : 0u;
      gb.nx = __hip_atomic_load(bw + 64 * x, __ATOMIC_RELAXED, __HIP_MEMORY_SCOPE_AGENT); gb.nxcd = n; gb.xarr = bw + 64 * (16 + x); gb.top = bw + 64 * 32; gb.epoch = 0; }
#define GBAR() grid_bar(gb)
    { pg8::StaticOrder S; S.init(T / 256, NIN / 256, G, c);
      EpiInProj E{qb, (const float*)(ws + WS_ROPE)};
      pg8::gemm_phase(lds, pg8::plain_gemm(h0, WIN, DM), S, E); }
    GBAR();
    { pg8::StaticOrder S; S.init(2, 8, G, c); EpiBf16 E = plain_epi(kx, DM); pg8::gemm_phase(lds, pg8::plain_gemm(memb, WXK, DM), S, E); }
    { pg8::StaticOrder S; S.init(2, 8, G, (c + G / 2) % G); EpiBf16 E = plain_epi(vx, DM); pg8::gemm_phase(lds, pg8::plain_gemm(memb, WXV, DM), S, E); }
    attn_phase(P, lds);
    if (PROBE_MASK & 2) attn_phase(P, lds);
    gating_phase(P, lds);
    if (PROBE_MASK & 4) gating_phase(P, lds);
    GBAR();
    { pg8::StaticOrder S; S.init(2, 32, G, c); pg8::Gemm g = pg8::make_gemm(kx, DM, WXQ, DM, 512); g.a_sh = 3; g.a_mask = 3; g.a_pn = 512; g.b_mask = 7; g.b_sh = 3; g.b_pn2 = 512;
      EpiBf16 E; E.O = Wqk; E.ldc = DM; E.pm_rows = 1024; E.rsh = 3; E.pn_rows = 256; E.cmask = 7; pg8::gemm_phase(lds, g, S, E); }
    { pg8::StaticOrder S; S.init(8, 8, G, (c + G / 2) % G); pg8::Gemm g = pg8::make_gemm(WXO, DM, vx, DM, 512); g.a_sh = 0; g.a_mask = 3; g.a_pn = 512; g.b_mask = 3; g.b_pn = 512; g.b_sh = 2; g.b_pn2 = 256L * DM;
      EpiBf16 E; E.O = VWo; E.ldc = 1024; E.pm_rows = 256; E.rsh = 2; E.pn_rows = 2048; E.cmask = 3; pg8::gemm_phase(lds, g, S, E); }
    merge_phase(P);
    GBAR();
    { pg8::StaticOrder S; S.init(T / 256, DM / 256, G, c); EpiResBf16 E{h0, y12}; pg8::gemm_phase(lds, pg8::plain_gemm(A2, WMIX, DM), S, E); }
    GBAR();
    ln_rows<true, false>(y12, P.ln1_g, P.ln1_b, h1, T);
    GBAR();
    { pg8::StaticOrder S; S.init(T / 256, 4, G, c);
      pg8::Gemm g = pg8::make_gemm(h1, DM, Wqk, DM, DM); g.b_pb = 1024L * DM;
      EpiWrap<EpiSoftmax> E{{Pm, 0.04419417382415922f * 1.4426950408889634f}}; pg8::gemm_phase(lds, g, S, E); }
    GBAR();
    { pg8::StaticOrder S; S.init(T / 256, DM / 256, G, c);
      pg8::Gemm g = pg8::make_gemm(Pm, 1024, VWo, 1024, 1024); g.b_pb = 2048L * 1024;
      EpiResBf16 E{h1, y12}; pg8::gemm_phase(lds, g, S, E); }
    GBAR();
    ln_rows<true, false>(y12, P.ln2_g, P.ln2_b, h2, T);
    GBAR();
    { pg8::StaticOrder S; S.init(T / 256, 2 * DFF / 256, G, c); EpiGateUp E{act}; pg8::gemm_phase(lds, pg8::plain_gemm(h2, WGU, DM), S, E);
      if (PROBE_MASK & 32) { GBAR(); pg8::gemm_phase(lds, pg8::plain_gemm(h2, WGU, DM), S, E); }
      if (PROBE_MASK & 64) { GBAR(); EpiNull EN{(float*)(ws + WS_LSE)}; pg8::gemm_phase(lds, pg8::plain_gemm(h2, WGU, DM), S, EN); } }
    GBAR();
    { pg8::StaticOrder S; S.init(T / 256, DM / 256, G, c); EpiResBf16 E{h2, y3}; pg8::gemm_phase(lds, pg8::plain_gemm(act, WDN, DFF), S, E); }
    GBAR();
    ln_rows<true, true>(y3, P.ln3_g, P.ln3_b, P.out, T);
    if (PROBE_MASK & 256) { for (int i = 0; i < 20; ++i) GBAR(); }
}

extern "C" void kernel_launch(void* const* d_in, const int* in_sizes, int n_in, void* d_out, int out_size, void* d_ws, size_t ws_size, hipStream_t stream) {
    static int grid_blocks = 0;
    if (!grid_blocks) {
        if (n_in != 26 || ws_size < WS_END) { fprintf(stderr, "kernel_launch: unexpected n_in %d / ws_size %zu\n", n_in, ws_size); grid_blocks = -1; return; }
        int dev = 0, cus = 0, per_cu = 0;
        (void)hipGetDevice(&dev);
        (void)hipDeviceGetAttribute(&cus, hipDeviceAttributeMultiprocessorCount, dev);
        if (hipFuncSetAttribute((const void*)mega_fwd, hipFuncAttributeMaxDynamicSharedMemorySize, LDS_BYTES) != hipSuccess) { fprintf(stderr, "hipFuncSetAttribute failed\n"); grid_blocks = -1; return; }
        if (hipOccupancyMaxActiveBlocksPerMultiprocessor(&per_cu, (const void*)mega_fwd, 512, LDS_BYTES) != hipSuccess || per_cu < 1) { fprintf(stderr, "occupancy query: %d\n", per_cu); per_cu = 1; }
        (void)hipGetLastError();
        grid_blocks = cus * 1;
    }
    if (grid_blocks < 0) return;
    Params p{};
    const float** fp = (const float**)&p;
    p.x = (const float*)d_in[0]; p.mem = (const float*)d_in[1]; p.pos = (const int*)d_in[2]; p.ln_in_g = (const float*)d_in[3]; p.ln_in_b = (const float*)d_in[4]; p.w_in = (const float*)d_in[5];
    p.sgu_g = (const float*)d_in[6]; p.sgu_b = (const float*)d_in[7]; p.w_sp = (const float*)d_in[8]; p.b_sp = (const float*)d_in[9]; p.attn_g = (const float*)d_in[10]; p.gmlp_g = (const float*)d_in[11]; p.w_mix = (const float*)d_in[12];
    p.ln1_g = (const float*)d_in[13]; p.ln1_b = (const float*)d_in[14]; p.w_xq = (const float*)d_in[15]; p.w_xk = (const float*)d_in[16]; p.w_xv = (const float*)d_in[17]; p.w_xo = (const float*)d_in[18];
    p.ln2_g = (const float*)d_in[19]; p.ln2_b = (const float*)d_in[20]; p.w_gate = (const float*)d_in[21]; p.w_up = (const float*)d_in[22]; p.w_down = (const float*)d_in[23]; p.ln3_g = (const float*)d_in[24]; p.ln3_b = (const float*)d_in[25];
    p.out = (float*)d_out; p.ws = (unsigned char*)d_ws; (void)fp; (void)out_size; (void)in_sizes;
    (void)hipMemsetAsync((unsigned char*)d_ws + WS_BAR, 0, 16384, stream);
    void* args[] = {&p};
    hipError_t e = hipLaunchCooperativeKernel((const void*)mega_fwd, dim3(grid_blocks), dim3(512), args, LDS_BYTES, stream);
    if (e != hipSuccess) fprintf(stderr, "cooperative launch failed: %s (grid %d)\n", hipGetErrorString(e), grid_blocks);
}
```
